# Optimizing an MI355X kernel written in HIP

```python
import math
import jax, jax.numpy as jnp
from jax import lax
import numpy as np

D_MODEL = 1024
BATCH = 4
SEQ = 4096
DEPTH = 1

HEAD_DIM = 64
DSA_WIDTH = D_MODEL // 2
DIFF_WIDTH = D_MODEL - DSA_WIDTH
N_DSA_HEADS = DSA_WIDTH // HEAD_DIM
DIFF_V_DIM = 2 * HEAD_DIM
N_DIFF_HEADS = DIFF_WIDTH // DIFF_V_DIM
N_IDX_HEADS = 8
IDX_DIM = 64
TOPK_MAX = 256
D_FF = 4 * D_MODEL
Q_BLOCK = 128
ROPE_THETA = 10000.0
NORM_EPS = 1e-6
LN_EPS = 1e-5

SPLIT_SIZES = (
    DSA_WIDTH,
    DSA_WIDTH,
    DSA_WIDTH,
    N_IDX_HEADS * IDX_DIM,
    IDX_DIM,
    N_IDX_HEADS,
    2 * N_DIFF_HEADS * HEAD_DIM,
    2 * N_DIFF_HEADS * HEAD_DIM,
    DIFF_WIDTH,
)
IN_WIDTH = sum(SPLIT_SIZES)
SPLIT_POINTS = tuple(int(p) for p in np.cumsum(SPLIT_SIZES)[:-1])

kernel_name = "hymba_dsa_diffattn_adaln_layer"


def lambda_init(layer_idx):
    return 0.8 - 0.6 * math.exp(-0.3 * layer_idx)


def rms_norm(x, gain):
    x32 = x.astype(jnp.float32)
    y = x32 * lax.rsqrt(jnp.mean(jnp.square(x32), axis=-1, keepdims=True) + NORM_EPS)
    return (y * gain.astype(jnp.float32)).astype(x.dtype)


def layer_norm(x, w, b):
    x32 = x.astype(jnp.float32)
    mu = jnp.mean(x32, axis=-1, keepdims=True)
    var = jnp.mean(jnp.square(x32 - mu), axis=-1, keepdims=True)
    y = (x32 - mu) * lax.rsqrt(var + LN_EPS) * w.astype(jnp.float32) + b.astype(jnp.float32)
    return y.astype(x.dtype)


def modulate(h, shift, scale):
    return h * (1.0 + scale[:, None, :]) + shift[:, None, :]


def rope(x, positions):
    d = x.shape[-1]
    half = d // 2
    inv_freq = ROPE_THETA ** (-jnp.arange(half, dtype=jnp.float32) / half)
    ang = positions.astype(jnp.float32)[..., None] * inv_freq
    cos = jnp.cos(ang)[:, :, None, :]
    sin = jnp.sin(ang)[:, :, None, :]
    x32 = x.astype(jnp.float32)
    x1, x2 = x32[..., :half], x32[..., half:]
    out = jnp.concatenate([x1 * cos - x2 * sin, x2 * cos + x1 * sin], axis=-1)
    return out.astype(x.dtype)


def dsa_attention(q, k, v, q_idx, k_idx, w_idx):
    B, L, H, dh = q.shape
    top_k = min(TOPK_MAX, L // 4)
    n_blocks = L // Q_BLOCK
    key_pos = jnp.arange(L)
    q32 = q.astype(jnp.float32) * (dh ** -0.5)
    k32 = k.astype(jnp.float32)
    v32 = v.astype(jnp.float32)
    qi32 = q_idx.astype(jnp.float32)
    ki32 = k_idx.astype(jnp.float32)
    wi32 = w_idx.astype(jnp.float32) * (N_IDX_HEADS ** -0.5) * (IDX_DIM ** -0.5)

    def block(i):
        start = i * Q_BLOCK
        qb = lax.dynamic_slice_in_dim(q32, start, Q_BLOCK, axis=1)
        qib = lax.dynamic_slice_in_dim(qi32, start, Q_BLOCK, axis=1)
        wb = lax.dynamic_slice_in_dim(wi32, start, Q_BLOCK, axis=1)
        q_pos = start + jnp.arange(Q_BLOCK)
        causal = key_pos[None, :] <= q_pos[:, None]
        rel = jax.nn.relu(jnp.einsum('bqhd,bsd->bqhs', qib, ki32))
        score = jnp.einsum('bqhs,bqh->bqs', rel, wb)
        score = jnp.where(causal[None], score, -jnp.inf)
        _, sel = lax.top_k(score, top_k)
        valid = sel <= q_pos[None, :, None]
        k_sel = jax.vmap(lambda kb, ib: kb[ib])(k32, sel)
        v_sel = jax.vmap(lambda vb, ib: vb[ib])(v32, sel)
        s = jnp.einsum('bqhd,bqkhd->bhqk', qb, k_sel)
        s = jnp.where(valid[:, None], s, -jnp.inf)
        p = jax.nn.softmax(s, axis=-1)
        return jnp.einsum('bhqk,bqkhd->bqhd', p, v_sel)

    out = lax.map(block, jnp.arange(n_blocks))
    out = jnp.transpose(out, (1, 0, 2, 3, 4)).reshape(B, L, H, dh)
    return out.astype(q.dtype)


def diff_attention(q, k, v, lam, subln_w, lam_init):
    B, L, H, _, dh = q.shape
    n_blocks = L // Q_BLOCK
    key_pos = jnp.arange(L)
    q32 = q.astype(jnp.float32) * (dh ** -0.5)
    k32 = k.astype(jnp.float32)
    v32 = v.astype(jnp.float32)

    def block(i):
        start = i * Q_BLOCK
        qb = lax.dynamic_slice_in_dim(q32, start, Q_BLOCK, axis=1)
        q_pos = start + jnp.arange(Q_BLOCK)
        causal = key_pos[None, :] <= q_pos[:, None]
        s = jnp.einsum('bqhcd,bshcd->bhcqs', qb, k32)
        s = jnp.where(causal[None, None, None], s, -jnp.inf)
        p = jax.nn.softmax(s, axis=-1)
        a = p[:, :, 0] - lam * p[:, :, 1]
        return jnp.einsum('bhqs,bshe->bqhe', a, v32)

    out = lax.map(block, jnp.arange(n_blocks))
    out = jnp.transpose(out, (1, 0, 2, 3, 4)).reshape(B, L, H, 2 * dh)
    out = out * lax.rsqrt(jnp.mean(jnp.square(out), axis=-1, keepdims=True) + NORM_EPS)
    out = out * subln_w.astype(jnp.float32) * (1.0 - lam_init)
    return out.astype(q.dtype)


def setup_inputs(seed: int = 0) -> dict:
    key = jax.random.key(seed)
    ks = jax.random.split(key, 20)
    f32 = jnp.float32
    D = D_MODEL
    x = jax.random.normal(ks[0], (BATCH, SEQ, D), f32)
    c = jax.random.normal(ks[1], (BATCH, D), f32)
    offset = jax.random.randint(ks[2], (BATCH, 1), 0, 1024, dtype=jnp.int32)
    positions = (jnp.arange(SEQ, dtype=jnp.int32)[None, :] + offset).astype(jnp.int32)
    w_ada = jax.random.normal(ks[3], (DEPTH, D, 6 * D), f32) * D ** -0.5
    b_ada = jax.random.normal(ks[4], (DEPTH, 6 * D), f32) * 0.02
    norm1_w = 1.0 + 0.02 * jax.random.normal(ks[5], (DEPTH, D), f32)
    w_in = jax.random.normal(ks[6], (DEPTH, D, IN_WIDTH), f32) * D ** -0.5
    idx_k_ln_w = 1.0 + 0.02 * jax.random.normal(ks[7], (DEPTH, IDX_DIM), f32)
    idx_k_ln_b = 0.02 * jax.random.normal(ks[8], (DEPTH, IDX_DIM), f32)
    lambda_q1 = 0.1 * jax.random.normal(ks[9], (DEPTH, HEAD_DIM), f32)
    lambda_k1 = 0.1 * jax.random.normal(ks[10], (DEPTH, HEAD_DIM), f32)
    lambda_q2 = 0.1 * jax.random.normal(ks[11], (DEPTH, HEAD_DIM), f32)
    lambda_k2 = 0.1 * jax.random.normal(ks[12], (DEPTH, HEAD_DIM), f32)
    subln_w = 1.0 + 0.02 * jax.random.normal(ks[13], (DEPTH, DIFF_V_DIM), f32)
    w_out = jax.random.normal(ks[14], (DEPTH, DSA_WIDTH + DIFF_WIDTH, D), f32) * (DSA_WIDTH + DIFF_WIDTH) ** -0.5
    norm2_w = 1.0 + 0.02 * jax.random.normal(ks[15], (DEPTH, D), f32)
    w_ff1 = jax.random.normal(ks[16], (DEPTH, D, D_FF), f32) * D ** -0.5
    w_ff2 = jax.random.normal(ks[17], (DEPTH, D_FF, D), f32) * D_FF ** -0.5
    norm_f_w = 1.0 + 0.02 * jax.random.normal(ks[18], (D,), f32)
    return {"x": x, "c": c, "positions": positions, "w_ada": w_ada, "b_ada": b_ada,
            "norm1_w": norm1_w, "w_in": w_in, "idx_k_ln_w": idx_k_ln_w, "idx_k_ln_b": idx_k_ln_b,
            "lambda_q1": lambda_q1, "lambda_k1": lambda_k1, "lambda_q2": lambda_q2, "lambda_k2": lambda_k2,
            "subln_w": subln_w, "w_out": w_out, "norm2_w": norm2_w, "w_ff1": w_ff1, "w_ff2": w_ff2,
            "norm_f_w": norm_f_w}


def reference(x, c, positions, w_ada, b_ada, norm1_w, w_in, idx_k_ln_w, idx_k_ln_b,
              lambda_q1, lambda_k1, lambda_q2, lambda_k2, subln_w, w_out, norm2_w,
              w_ff1, w_ff2, norm_f_w):
    B, L, D = x.shape
    for l in range(DEPTH):
        mod = jnp.dot(jax.nn.silu(c), w_ada[l]) + b_ada[l]
        sh1, sc1, g1, sh2, sc2, g2 = jnp.split(mod, 6, axis=-1)

        h = modulate(rms_norm(x, norm1_w[l]), sh1, sc1)
        proj = jnp.dot(h, w_in[l])
        (a_q, a_k, a_v, i_q, i_k, i_w, d_q, d_k, d_v) = jnp.split(proj, SPLIT_POINTS, axis=-1)

        a_q = rope(a_q.reshape(B, L, N_DSA_HEADS, HEAD_DIM), positions)
        a_k = rope(a_k.reshape(B, L, N_DSA_HEADS, HEAD_DIM), positions)
        a_v = a_v.reshape(B, L, N_DSA_HEADS, HEAD_DIM)
        i_q = rope(i_q.reshape(B, L, N_IDX_HEADS, IDX_DIM), positions)
        i_k = layer_norm(i_k, idx_k_ln_w[l], idx_k_ln_b[l])
        i_k = rope(i_k[:, :, None, :], positions)[:, :, 0, :]
        out_a = dsa_attention(a_q, a_k, a_v, i_q, i_k, i_w)

        d_q = rope(d_q.reshape(B, L, 2 * N_DIFF_HEADS, HEAD_DIM), positions)
        d_k = rope(d_k.reshape(B, L, 2 * N_DIFF_HEADS, HEAD_DIM), positions)
        d_q = d_q.reshape(B, L, N_DIFF_HEADS, 2, HEAD_DIM)
        d_k = d_k.reshape(B, L, N_DIFF_HEADS, 2, HEAD_DIM)
        d_v = d_v.reshape(B, L, N_DIFF_HEADS, DIFF_V_DIM)
        lam_init = lambda_init(l)
        lam = (jnp.exp(jnp.sum(lambda_q1[l].astype(jnp.float32) * lambda_k1[l].astype(jnp.float32)))
               - jnp.exp(jnp.sum(lambda_q2[l].astype(jnp.float32) * lambda_k2[l].astype(jnp.float32)))
               + lam_init)
        out_b = diff_attention(d_q, d_k, d_v, lam, subln_w[l], lam_init)

        mix = jnp.concatenate([out_a.reshape(B, L, DSA_WIDTH),
                               out_b.reshape(B, L, DIFF_WIDTH)], axis=-1)
        x = x + g1[:, None, :] * jnp.dot(mix, w_out[l])

        h = modulate(rms_norm(x, norm2_w[l]), sh2, sc2)
        ff = jnp.dot(jnp.square(jax.nn.relu(jnp.dot(h, w_ff1[l]))), w_ff2[l])
        x = x + g2[:, None, :] * ff
    return rms_norm(x, norm_f_w)
```

```cpp
#include <hip/hip_runtime.h>
#include <cstdint>
#include <cmath>
#include <cstring>

namespace nv {
constexpr int B = 4, L = 4096, D = 1024, M = B * L, FF = 4096, INW = 3656;
constexpr int C_AQ = 0, C_AK = 512, C_AV = 1024, C_IQ = 1536, C_IK = 2048, C_IW = 2112, C_DQ = 2120, C_DK = 2632, C_DV = 3144;
constexpr int TOPK = 256;

__device__ __forceinline__ float wave_sum(float v) {
#pragma unroll
    for (int o = 1; o < 64; o <<= 1) v += __shfl_xor(v, o);
    return v;
}
__device__ __forceinline__ float wave_max(float v) {
#pragma unroll
    for (int o = 1; o < 64; o <<= 1) v = fmaxf(v, __shfl_xor(v, o));
    return v;
}

__global__ void __launch_bounds__(256) k_mod(const float* __restrict__ c, const float* __restrict__ w_ada, const float* __restrict__ b_ada, float* __restrict__ mod) {
    __shared__ float sc[4][1024];
    __shared__ float red[4][4][64];
    const int tid = threadIdx.x;
    for (int i = tid; i < 4096; i += 256) { const float v = c[i]; sc[i >> 10][i & 1023] = v / (1.f + expf(-v)); }
    __syncthreads();
    const int jl = tid & 63, kp = tid >> 6, j = blockIdx.x * 64 + jl;
    float a0 = 0.f, a1 = 0.f, a2 = 0.f, a3 = 0.f;
    for (int k = kp; k < 1024; k += 4) { const float w = w_ada[(size_t)k * 6144 + j]; a0 += sc[0][k] * w; a1 += sc[1][k] * w; a2 += sc[2][k] * w; a3 += sc[3][k] * w; }
    red[kp][0][jl] = a0; red[kp][1][jl] = a1; red[kp][2][jl] = a2; red[kp][3][jl] = a3;
    __syncthreads();
    if (tid < 256) { const int b = tid >> 6; const float s = red[0][b][jl] + red[1][b][jl] + red[2][b][jl] + red[3][b][jl]; mod[b * 6144 + j] = s + b_ada[j]; }
}

__global__ void __launch_bounds__(256) k_rstd(const float* __restrict__ x, float* __restrict__ rstd, float eps) {
    const int row = blockIdx.x * 4 + (threadIdx.x >> 6), lane = threadIdx.x & 63;
    const float4* xr = (const float4*)(x + (size_t)row * D);
    float s = 0.f;
#pragma unroll
    for (int j = 0; j < 4; ++j) { const float4 v = xr[lane + 64 * j]; s += v.x * v.x + v.y * v.y + v.z * v.z + v.w * v.w; }
    s = wave_sum(s);
    if (lane == 0) rstd[row] = rsqrtf(s * (1.f / D) + eps);
}

struct GemmP { const float* A; const float* W; float* C; const float* rstd; const float* nw; const float* sc; const float* sh; const float* resid; const float* gate; int Mrows, N, K, ldc, row0, pad0, pad1, pad2; };
static GemmP mk(const float* A, const float* W, float* C, int Mrows, int N, int K, int ldc, const float* rstd, const float* nw, const float* sc, const float* sh, const float* resid, const float* gate, int row0) {
    GemmP p; memset(&p, 0, sizeof(p)); p.A = A; p.W = W; p.C = C; p.Mrows = Mrows; p.N = N; p.K = K; p.ldc = ldc; p.rstd = rstd; p.nw = nw; p.sc = sc; p.sh = sh; p.resid = resid; p.gate = gate; p.row0 = row0; return p; }
template <int AMODE, int EPI>
__global__ void __launch_bounds__(256) k_gemm(GemmP p) {
    constexpr int BM = 128, BN = 128, BK = 8;
    __shared__ float As[BK][BM + 4];
    __shared__ float Bs[BK][BN + 4];
    const int tid = threadIdx.x, tx = tid & 15, ty = tid >> 4;
    const int m0 = blockIdx.y * BM, n0 = blockIdx.x * BN;
    float acc[8][8];
#pragma unroll
    for (int i = 0; i < 8; ++i)
#pragma unroll
        for (int j = 0; j < 8; ++j) acc[i][j] = 0.f;
    const int ar = tid >> 1, ak = (tid & 1) * 4;
    const int grow = p.row0 + m0 + ar;
    const int bb = grow / L;
    const float rs = (AMODE == 1) ? p.rstd[grow] : 1.f;
    const int bk = tid >> 5, bn = (tid & 31) * 4;
    for (int k0 = 0; k0 < p.K; k0 += BK) {
        float4 av = *(const float4*)(p.A + (size_t)(AMODE == 1 ? grow : (m0 + ar)) * p.K + k0 + ak);
        if (AMODE == 1) {
            const float4 nw = *(const float4*)(p.nw + k0 + ak), sc = *(const float4*)(p.sc + bb * 6144 + k0 + ak), sh = *(const float4*)(p.sh + bb * 6144 + k0 + ak);
            av.x = (av.x * rs * nw.x) * (1.f + sc.x) + sh.x; av.y = (av.y * rs * nw.y) * (1.f + sc.y) + sh.y;
            av.z = (av.z * rs * nw.z) * (1.f + sc.z) + sh.z; av.w = (av.w * rs * nw.w) * (1.f + sc.w) + sh.w;
        }
        As[ak + 0][ar] = av.x; As[ak + 1][ar] = av.y; As[ak + 2][ar] = av.z; As[ak + 3][ar] = av.w;
        {
            const int n = n0 + bn; const float* wp = p.W + (size_t)(k0 + bk) * p.N + n;
            float4 bv;
            if (n + 3 < p.N) bv = *(const float4*)wp;
            else { bv.x = n < p.N ? wp[0] : 0.f; bv.y = n + 1 < p.N ? wp[1] : 0.f; bv.z = n + 2 < p.N ? wp[2] : 0.f; bv.w = 0.f; }
            *(float4*)&Bs[bk][bn] = bv;
        }
        __syncthreads();
#pragma unroll
        for (int kk = 0; kk < BK; ++kk) {
            float a[8], b[8];
            const float4 a0 = *(const float4*)&As[kk][ty * 4], a1 = *(const float4*)&As[kk][64 + ty * 4];
            const float4 b0 = *(const float4*)&Bs[kk][tx * 4], b1 = *(const float4*)&Bs[kk][64 + tx * 4];
            a[0] = a0.x; a[1] = a0.y; a[2] = a0.z; a[3] = a0.w; a[4] = a1.x; a[5] = a1.y; a[6] = a1.z; a[7] = a1.w;
            b[0] = b0.x; b[1] = b0.y; b[2] = b0.z; b[3] = b0.w; b[4] = b1.x; b[5] = b1.y; b[6] = b1.z; b[7] = b1.w;
#pragma unroll
            for (int i = 0; i < 8; ++i)
#pragma unroll
                for (int j = 0; j < 8; ++j) acc[i][j] += a[i] * b[j];
        }
        __syncthreads();
    }
#pragma unroll
    for (int i = 0; i < 8; ++i) {
        const int lr = m0 + (i < 4 ? ty * 4 + i : 64 + ty * 4 + (i - 4));
        const int gr = p.row0 + lr; const int b2 = gr / L;
#pragma unroll
        for (int j = 0; j < 8; ++j) {
            const int col = n0 + (j < 4 ? tx * 4 + j : 64 + tx * 4 + (j - 4));
            if (col < p.N) {
                float v = acc[i][j];
                if (EPI == 1) { v = fmaxf(v, 0.f); v = v * v; }
                if (EPI == 2) v = p.resid[(size_t)gr * p.ldc + col] + p.gate[b2 * 6144 + col] * v;
                p.C[(size_t)(EPI == 2 ? gr : lr) * p.ldc + col] = v;
            }
        }
    }
}

__global__ void __launch_bounds__(256) k_rope(float* __restrict__ proj, const int* __restrict__ positions, const float* __restrict__ lnw, const float* __restrict__ lnb) {
    const int row = blockIdx.x, tid = threadIdx.x;
    __shared__ float cs[32], sn[32];
    if (tid < 32) {
        const float inv = (float)pow(10000.0, -(double)tid / 32.0);
        const float ang = (float)positions[row] * inv;
        cs[tid] = (float)cos((double)ang); sn[tid] = (float)sin((double)ang);
    }
    __syncthreads();
    float* pr = proj + (size_t)row * INW;
    for (int e = tid; e < 1280; e += 256) {
        const int hh = e >> 5, j = e & 31; int base;
        if (hh < 8) base = C_AQ + hh * 64; else if (hh < 16) base = C_AK + (hh - 8) * 64; else if (hh < 24) base = C_IQ + (hh - 16) * 64;
        else if (hh < 32) base = C_DQ + (hh - 24) * 64; else base = C_DK + (hh - 32) * 64;
        const float x1 = pr[base + j], x2 = pr[base + 32 + j];
        pr[base + j] = x1 * cs[j] - x2 * sn[j]; pr[base + 32 + j] = x2 * cs[j] + x1 * sn[j];
    }
    if (tid < 64) {
        const float v = pr[C_IK + tid];
        const float mu = wave_sum(v) * (1.f / 64.f);
        const float dv = v - mu;
        const float var = wave_sum(dv * dv) * (1.f / 64.f);
        const float y = dv * rsqrtf(var + 1e-5f) * lnw[tid] + lnb[tid];
        const float other = __shfl_xor(y, 32);
        const int j = tid & 31;
        const float o = tid < 32 ? y * cs[j] - other * sn[j] : y * cs[j] + other * sn[j];
        pr[C_IK + tid] = o;
    }
    if (tid >= 64 && tid < 72) pr[C_IW + tid - 64] *= 0.35355339059327373f * 0.125f;
}

__device__ __forceinline__ unsigned fkey(float f) { const unsigned u = __float_as_uint(f); return (u & 0x80000000u) ? ~u : (u | 0x80000000u); }

__global__ void __launch_bounds__(256) k_dsa(const float* __restrict__ proj, float* __restrict__ mix) {
    const int row = blockIdx.x, b = row / L, t = row % L, tid = threadIdx.x, lane = tid & 63, wid = tid >> 6;
    __shared__ float sI[L];
    __shared__ float sq[512];
    __shared__ int sel[TOPK];
    __shared__ int s_cnt; __shared__ float s_red[8]; __shared__ int s_nsel;
    __shared__ float sp[TOPK]; __shared__ float so[4][64];
    const float* prow = proj + (size_t)row * INW;
    const float* pb = proj + (size_t)b * L * INW;
    int nsel;
    if (t < TOPK) { nsel = t + 1; for (int s = tid; s <= t; s += 256) sel[s] = s; __syncthreads(); }
    else {
        for (int i = tid; i < 512; i += 256) sq[i] = prow[C_IQ + i];
        __shared__ float sw[8];
        if (tid < 8) sw[tid] = prow[C_IW + tid];
        __syncthreads();
        for (int s = tid; s <= t; s += 256) {
            const float* kr = pb + (size_t)s * INW + C_IK;
            float kv[64];
#pragma unroll
            for (int d = 0; d < 64; d += 4) { const float4 v = *(const float4*)(kr + d); kv[d] = v.x; kv[d + 1] = v.y; kv[d + 2] = v.z; kv[d + 3] = v.w; }
            float sc = 0.f;
            for (int h = 0; h < 8; ++h) { float dot = 0.f;
#pragma unroll
                for (int d = 0; d < 64; ++d) dot += sq[h * 64 + d] * kv[d];
                sc += fmaxf(dot, 0.f) * sw[h]; }
            sI[s] = sc;
        }
        __syncthreads();
        unsigned T = 0u;
        for (int bit = 31; bit >= 0; --bit) {
            const unsigned cand = T | (1u << bit);
            if (tid == 0) s_cnt = 0;
            __syncthreads();
            int c = 0;
            for (int s = tid; s <= t; s += 256) c += (fkey(sI[s]) >= cand) ? 1 : 0;
            c = (int)wave_sum((float)c);
            if (lane == 0) atomicAdd(&s_cnt, c);
            __syncthreads();
            if (s_cnt >= TOPK) T = cand;
            __syncthreads();
        }
        if (tid == 0) { s_cnt = 0; s_nsel = 0; }
        __syncthreads();
        { int c = 0; for (int s = tid; s <= t; s += 256) c += (fkey(sI[s]) > T) ? 1 : 0; c = (int)wave_sum((float)c); if (lane == 0) atomicAdd(&s_cnt, c); }
        __syncthreads();
        const int need = TOPK - s_cnt;
        for (int s = tid; s <= t; s += 256) {
            const unsigned k = fkey(sI[s]); bool take = k > T;
            if (k == T) { int rank = 0; for (int s2 = 0; s2 < s; ++s2) rank += (fkey(sI[s2]) == T) ? 1 : 0; take = rank < need; }
            if (take) { const int pos = atomicAdd(&s_nsel, 1); if (pos < TOPK) sel[pos] = s; }
        }
        __syncthreads();
        nsel = TOPK;
    }
    for (int h = 0; h < 8; ++h) {
        __syncthreads();
        if (tid < 64) sq[tid] = prow[C_AQ + h * 64 + tid] * 0.125f;
        __syncthreads();
        float sc = -INFINITY;
        if (tid < nsel) { const float* kr = pb + (size_t)sel[tid] * INW + C_AK + h * 64; float dot = 0.f;
#pragma unroll
            for (int d = 0; d < 64; d += 4) { const float4 v = *(const float4*)(kr + d); dot += sq[d] * v.x + sq[d + 1] * v.y + sq[d + 2] * v.z + sq[d + 3] * v.w; }
            sc = dot; }
        float m = wave_max(sc);
        if (lane == 0) s_red[wid] = m;
        __syncthreads();
        m = fmaxf(fmaxf(s_red[0], s_red[1]), fmaxf(s_red[2], s_red[3]));
        const float e = tid < nsel ? expf(sc - m) : 0.f;
        float sm = wave_sum(e);
        if (lane == 0) s_red[4 + wid] = sm;
        sp[tid] = e;
        __syncthreads();
        sm = s_red[4] + s_red[5] + s_red[6] + s_red[7];
        float o = 0.f;
        for (int i = wid; i < nsel; i += 4) o += sp[i] * pb[(size_t)sel[i] * INW + C_AV + h * 64 + lane];
        so[wid][lane] = o;
        __syncthreads();
        if (tid < 64) mix[(size_t)row * D + h * 64 + tid] = (so[0][tid] + so[1][tid] + so[2][tid] + so[3][tid]) / sm;
    }
}

__global__ void __launch_bounds__(256) k_diff(const float* __restrict__ proj, float* __restrict__ mix, const float* __restrict__ lq1, const float* __restrict__ lk1,
                                              const float* __restrict__ lq2, const float* __restrict__ lk2, const float* __restrict__ subln) {
    const int row = blockIdx.x >> 2, h = blockIdx.x & 3, b = row / L, t = row % L, tid = threadIdx.x, lane = tid & 63, wid = tid >> 6;
    __shared__ float sa[L]; __shared__ float sb2[L];
    __shared__ float sq[128]; __shared__ float red[16]; __shared__ float so[2][128];
    const float* prow = proj + (size_t)row * INW; const float* pb = proj + (size_t)b * L * INW;
    if (tid < 128) sq[tid] = prow[C_DQ + h * 128 + tid] * 0.125f;
    __syncthreads();
    float m0 = -INFINITY, m1 = -INFINITY;
    for (int s = tid; s <= t; s += 256) {
        const float* kr = pb + (size_t)s * INW + C_DK + h * 128; float d0 = 0.f, d1 = 0.f;
#pragma unroll
        for (int d = 0; d < 64; d += 4) { const float4 v = *(const float4*)(kr + d), w = *(const float4*)(kr + 64 + d);
            d0 += sq[d] * v.x + sq[d + 1] * v.y + sq[d + 2] * v.z + sq[d + 3] * v.w; d1 += sq[64 + d] * w.x + sq[65 + d] * w.y + sq[66 + d] * w.z + sq[67 + d] * w.w; }
        sa[s] = d0; sb2[s] = d1; m0 = fmaxf(m0, d0); m1 = fmaxf(m1, d1);
    }
    m0 = wave_max(m0); m1 = wave_max(m1);
    if (lane == 0) { red[wid] = m0; red[4 + wid] = m1; }
    __syncthreads();
    m0 = fmaxf(fmaxf(red[0], red[1]), fmaxf(red[2], red[3])); m1 = fmaxf(fmaxf(red[4], red[5]), fmaxf(red[6], red[7]));
    float s0 = 0.f, s1 = 0.f;
    for (int s = tid; s <= t; s += 256) { const float e0 = expf(sa[s] - m0), e1 = expf(sb2[s] - m1); sa[s] = e0; sb2[s] = e1; s0 += e0; s1 += e1; }
    s0 = wave_sum(s0); s1 = wave_sum(s1);
    if (lane == 0) { red[8 + wid] = s0; red[12 + wid] = s1; }
    __syncthreads();
    s0 = red[8] + red[9] + red[10] + red[11]; s1 = red[12] + red[13] + red[14] + red[15];
    float a1 = 0.f, a2 = 0.f;
    if (tid < 64) { a1 = lq1[tid] * lk1[tid]; a2 = lq2[tid] * lk2[tid]; }
    __shared__ float s_lam;
    if (wid == 0) { a1 = wave_sum(a1); a2 = wave_sum(a2); if (lane == 0) s_lam = expf(a1) - expf(a2) + 0.2f; }
    __syncthreads();
    const float lam = s_lam, r0 = 1.f / s0, r1 = lam / s1;
    for (int s = tid; s <= t; s += 256) sa[s] = sa[s] * r0 - sb2[s] * r1;
    __syncthreads();
    const int e = tid & 127, part = tid >> 7;
    float o = 0.f;
    for (int s = part; s <= t; s += 2) o += sa[s] * pb[(size_t)s * INW + C_DV + h * 128 + e];
    so[part][e] = o;
    __syncthreads();
    float v = 0.f;
    if (tid < 128) v = so[0][tid] + so[1][tid];
    float ss = wave_sum(v * v);
    if (tid < 128 && lane == 0) red[wid] = ss;
    __syncthreads();
    if (tid < 128) { const float rms = rsqrtf((red[0] + red[1]) * (1.f / 128.f) + 1e-6f); mix[(size_t)row * D + 512 + h * 128 + tid] = v * rms * subln[tid] * 0.8f; }
}

__global__ void __launch_bounds__(256) k_final(float* __restrict__ x, const float* __restrict__ w) {
    const int row = blockIdx.x * 4 + (threadIdx.x >> 6), lane = threadIdx.x & 63;
    float4* xr = (float4*)(x + (size_t)row * D); const float4* wr = (const float4*)w;
    float4 v[4]; float s = 0.f;
#pragma unroll
    for (int j = 0; j < 4; ++j) { v[j] = xr[lane + 64 * j]; s += v[j].x * v[j].x + v[j].y * v[j].y + v[j].z * v[j].z + v[j].w * v[j].w; }
    s = wave_sum(s);
    const float r = rsqrtf(s * (1.f / D) + 1e-6f);
#pragma unroll
    for (int j = 0; j < 4; ++j) { const float4 g = wr[lane + 64 * j]; float4 o; o.x = v[j].x * r * g.x; o.y = v[j].y * r * g.y; o.z = v[j].z * r * g.z; o.w = v[j].w * r * g.w; xr[lane + 64 * j] = o; }
}
}

extern "C" void kernel_launch(void* const* d_in, const int* in_sizes, int n_in, void* d_out, int out_size, void* d_ws, size_t ws_size, hipStream_t stream) {
    using namespace nv;
    const float* x = (const float*)d_in[0]; const float* c = (const float*)d_in[1]; const int* pos = (const int*)d_in[2];
    const float* w_ada = (const float*)d_in[3]; const float* b_ada = (const float*)d_in[4]; const float* norm1_w = (const float*)d_in[5];
    const float* w_in = (const float*)d_in[6]; const float* lnw = (const float*)d_in[7]; const float* lnb = (const float*)d_in[8];
    const float* lq1 = (const float*)d_in[9]; const float* lk1 = (const float*)d_in[10]; const float* lq2 = (const float*)d_in[11]; const float* lk2 = (const float*)d_in[12];
    const float* subln = (const float*)d_in[13]; const float* w_out = (const float*)d_in[14]; const float* norm2_w = (const float*)d_in[15];
    const float* w_ff1 = (const float*)d_in[16]; const float* w_ff2 = (const float*)d_in[17]; const float* norm_f = (const float*)d_in[18];
    float* out = (float*)d_out; char* ws = (char*)d_ws;
    float* mod = (float*)ws;
    float* rstd1 = (float*)(ws + 128 * 1024);
    float* rstd2 = (float*)(ws + 256 * 1024);
    float* proj = (float*)(ws + (1u << 20));
    float* x1 = proj;
    float* hbuf = (float*)(ws + (1u << 20) + (size_t)M * D * 4);
    float* mix = out;

    k_mod<<<96, 256, 0, stream>>>(c, w_ada, b_ada, mod);
    k_rstd<<<M / 4, 256, 0, stream>>>(x, rstd1, 1e-6f);
    { GemmP p = mk(x, w_in, proj, M, INW, D, INW, rstd1, norm1_w, mod + 1024, mod + 0, nullptr, nullptr, 0);
      k_gemm<1, 0><<<dim3((INW + 127) / 128, M / 128), 256, 0, stream>>>(p); }
    k_rope<<<M, 256, 0, stream>>>(proj, pos, lnw, lnb);
    k_dsa<<<M, 256, 0, stream>>>(proj, mix);
    k_diff<<<M * 4, 256, 0, stream>>>(proj, mix, lq1, lk1, lq2, lk2, subln);
    { GemmP p = mk(mix, w_out, x1, M, D, D, D, nullptr, nullptr, nullptr, nullptr, x, mod + 2048, 0);
      k_gemm<0, 2><<<dim3(D / 128, M / 128), 256, 0, stream>>>(p); }
    k_rstd<<<M / 4, 256, 0, stream>>>(x1, rstd2, 1e-6f);
    for (int ch = 0; ch < 4; ++ch) {
        const int r0 = ch * 4096;
        { GemmP p = mk(x1, w_ff1, hbuf, 4096, FF, D, FF, rstd2, norm2_w, mod + 4096, mod + 3072, nullptr, nullptr, r0);
          k_gemm<1, 1><<<dim3(FF / 128, 4096 / 128), 256, 0, stream>>>(p); }
        { GemmP p = mk(hbuf, w_ff2, out, 4096, D, FF, D, nullptr, nullptr, nullptr, nullptr, x1, mod + 5120, r0);
          k_gemm<0, 2><<<dim3(D / 128, 4096 / 128), 256, 0, stream>>>(p); }
    }
    k_final<<<M / 4, 256, 0, stream>>>(out, norm_f);
}
```

```cpp
#include <hip/hip_runtime.h>
#include <cstdio>
#include <cstdint>
#include <cstring>
namespace pg8 {
#define PG8_LAS __attribute__((address_space(3)))
typedef unsigned short bf16_t;
typedef short bf16x8 __attribute__((ext_vector_type(8)));
typedef float f32x4 __attribute__((ext_vector_type(4)));
typedef unsigned u32x4 __attribute__((ext_vector_type(4)));
constexpr int BM = 256, BK = 64, HALF = 128, HTB = HALF * BK * 2  , STAGE_BYTES = 8 * HTB, NXCD = 8, WGM = 8;

__host__ __device__ __forceinline__ int lds_byte(int r, int c) { const int st = (r >> 4) * 2 + (c >> 5), rr = r & 15, cc = c & 31, ob = rr * 64 + cc * 2; return st * 1024 + (ob ^ (((ob >> 9) & 1) << 5)); }
__host__ __device__ __forceinline__ void stage_rc(int b, int& R, int& C) { const int st = b / 1024, sb = b % 1024, swz = sb ^ (((sb >> 9) & 1) << 5); R = (st >> 1) * 16 + swz / 64; C = (st & 1) * 32 + (swz % 64) / 2; }
__host__ __device__ __forceinline__ int perm32(int rho) { const int n = rho >> 4, i = rho & 15; return 8 * (i >> 2) + 4 * n + (i & 3); }

struct Unit { int pm, pn; };
struct Gemm { const bf16_t* A; const bf16_t* Bt; int M, N, K; };

struct StaticOrder {
    int nM, nN, nwg, G, c;
    __host__ __device__ void init(int M, int N, int G_, int c_) { nM = M / BM; nN = N / BM; nwg = nM * nN; G = G_; c = c_; }
    __host__ __device__ bool next(int i, Unit& u) const {
        const long L = (long)i * G + c; if (L >= nwg) return false;
        int wgid = (int)L; { const int q = nwg / NXCD, r = nwg % NXCD, xcd = wgid % NXCD, off = wgid / NXCD; wgid = (xcd < r ? xcd * (q + 1) : r * (q + 1) + (xcd - r) * q) + off; }
        const int nig = WGM * nN, gid = wgid / nig, fm = gid * WGM, gsz = (nM - fm) < WGM ? (nM - fm) : WGM;
        u.pm = fm + ((wgid % nig) % gsz); u.pn = (wgid % nig) / gsz; return true;
    }
    __device__ __forceinline__ void a_ready(const Unit&) const {}
    __device__ __forceinline__ void done(const Unit&) const {}
};

__device__ __forceinline__ unsigned cvt_pk_bf16(float lo, float hi) { unsigned r; asm volatile("v_cvt_pk_bf16_f32 %0, %1, %2" : "=v"(r) : "v"(lo), "v"(hi)); return r; }

template <int ACT  > struct EpiBf16 {
    static constexpr bool PERM = true, AFTER_DRAIN = false;
    bf16_t* O; int ldc;
    __device__ __forceinline__ void operator()(const f32x4 (&acc)[2][2][4][2], const Unit& u, int wr, int wc, int fr, int fq) const {
        const int row0 = u.pm * BM + wr * 64 + fr; const int col0 = u.pn * BM + wc * 32 + 8 * fq;
#pragma unroll
        for (int ai = 0; ai < 2; ++ai)
#pragma unroll
            for (int m = 0; m < 4; ++m) { bf16_t* rowp = O + (size_t)(row0 + ai * HALF + m * 16) * ldc + col0;
#pragma unroll
                for (int bj = 0; bj < 2; ++bj) { f32x4 v0 = acc[ai][bj][m][0], v1 = acc[ai][bj][m][1];
                    if (ACT == 2) {
#pragma unroll
                        for (int e = 0; e < 4; ++e) { const float a = __builtin_fmaxf(v0[e], 0.f), b = __builtin_fmaxf(v1[e], 0.f); v0[e] = a * a; v1[e] = b * b; } }
                    u32x4 w; w.x = cvt_pk_bf16(v0[0], v0[1]); w.y = cvt_pk_bf16(v0[2], v0[3]); w.z = cvt_pk_bf16(v1[0], v1[1]); w.w = cvt_pk_bf16(v1[2], v1[3]);
                    *(u32x4*)(rowp + bj * HALF) = w; } }
    }
};

struct EpiResGate {
    static constexpr bool PERM = true, AFTER_DRAIN = false;
    const float* resid; float* out; const float* gate; int ldc; int rows_per_batch; int gate_stride;
    __device__ __forceinline__ void operator()(const f32x4 (&acc)[2][2][4][2], const Unit& u, int wr, int wc, int fr, int fq) const {
        const int row0 = u.pm * BM + wr * 64 + fr; const int col0 = u.pn * BM + wc * 32 + 8 * fq;
        const float* g = gate + (size_t)((u.pm * BM) / rows_per_batch) * gate_stride + col0;
        f32x4 gv[2][2];
#pragma unroll
        for (int bj = 0; bj < 2; ++bj) { gv[bj][0] = *(const f32x4*)(g + bj * HALF); gv[bj][1] = *(const f32x4*)(g + bj * HALF + 4); }
#pragma unroll
        for (int ai = 0; ai < 2; ++ai)
#pragma unroll
            for (int m = 0; m < 4; ++m) { const size_t off = (size_t)(row0 + ai * HALF + m * 16) * ldc + col0;
#pragma unroll
                for (int bj = 0; bj < 2; ++bj) {
                    const f32x4 r0 = *(const f32x4*)(resid + off + bj * HALF), r1 = *(const f32x4*)(resid + off + bj * HALF + 4);
                    *(f32x4*)(out + off + bj * HALF) = r0 + gv[bj][0] * acc[ai][bj][m][0];
                    *(f32x4*)(out + off + bj * HALF + 4) = r1 + gv[bj][1] * acc[ai][bj][m][1]; } }
    }
};

struct EpiInProj {
    static constexpr bool PERM = true, AFTER_DRAIN = false;
    bf16_t* qkv;
    float* raw;
    const float* cosT; const float* sinT;
    float c2; int Mrows;
    __device__ __forceinline__ void operator()(const f32x4 (&acc)[2][2][4][2], const Unit& u, int wr, int wc, int fr, int fq) const {
        const int pn = u.pn; const int row0 = u.pm * BM + wr * 64 + fr;
        if (pn == 8) {
            const int c = wc * 32 + 8 * fq;
            if (c < 72) {
#pragma unroll
                for (int ai = 0; ai < 2; ++ai)
#pragma unroll
                    for (int m = 0; m < 4; ++m) { float* rp = raw + (size_t)(row0 + ai * HALF + m * 16) * 80 + c;
                        *(f32x4*)rp = acc[ai][0][m][0]; *(f32x4*)(rp + 4) = acc[ai][0][m][1]; } }
            return;
        }
        const int t = pn < 8 ? pn : pn - 9; const int bi = (pn < 8 ? 0 : 4) + (t >> 1); const int colbase = (t & 1) * 256;
        bf16_t* base = qkv + (size_t)bi * Mrows * 512;
        const bool rope = !(bi == 2 || bi == 6); const float sc = (bi == 0 || bi == 4) ? c2 : 1.f;
        const int col0 = colbase + wc * 32 + 8 * fq; const int j0 = 16 * (wc & 1) + 4 * fq;
#pragma unroll
        for (int ai = 0; ai < 2; ++ai)
#pragma unroll
            for (int m = 0; m < 4; ++m) { const int row = row0 + ai * HALF + m * 16; bf16_t* rowp = base + (size_t)row * 512 + col0;
                f32x4 cs = {sc, sc, sc, sc}, sn = {0.f, 0.f, 0.f, 0.f};
                if (rope) { cs = *(const f32x4*)(cosT + (size_t)row * 32 + j0) * sc; sn = *(const f32x4*)(sinT + (size_t)row * 32 + j0) * sc; }
#pragma unroll
                for (int bj = 0; bj < 2; ++bj) { const f32x4 x1 = acc[ai][bj][m][0], x2 = acc[ai][bj][m][1];
                    const f32x4 o1 = x1 * cs - x2 * sn, o2 = x2 * cs + x1 * sn;
                    u32x4 w; w.x = cvt_pk_bf16(o1[0], o1[1]); w.y = cvt_pk_bf16(o1[2], o1[3]); w.z = cvt_pk_bf16(o2[0], o2[1]); w.w = cvt_pk_bf16(o2[2], o2[3]);
                    *(u32x4*)(rowp + bj * HALF) = w; } }
    }
};

template <class Epi, class Sched, bool ALIGN_EPI = false, bool SP2 = false>
__device__ __forceinline__ void gemm_phase(PG8_LAS unsigned char* lds, const Gemm g, const Sched& S, const Epi& E, const int tid  ) {
    const int wid = __builtin_amdgcn_readfirstlane(tid >> 6), lane = tid & 63, wr = wid >> 2, wc = wid & 3, fr = lane & 15, fq = lane >> 4;
    const int K = g.K, nt = K / BK;
    unsigned voffA[2], voffB[2];
#pragma unroll
    for (int i = 0; i < 2; ++i) { int R, C; stage_rc(tid * 16 + i * 8192, R, C); const int Rb = Epi::PERM ? ((R & ~31) + perm32(R & 31)) : R;
        voffA[i] = (unsigned)(R * K + C) * 2u; voffB[i] = (unsigned)(Rb * K + C) * 2u; }
    const size_t kstep = (size_t)(BK * 2);
    const size_t hstep = (size_t)HALF * K * 2;
    const size_t tstep = 2 * hstep;
    const unsigned ldsw = (unsigned)wid * 1024u;
    const int aoff = lds_byte(wr * 64 + fr, fq * 8), boff = lds_byte(wc * 32 + fr, fq * 8);
#define PG8_SA(b, h) (((b) * 2 + (h)) * HTB)
#define PG8_SB(b, h) ((4 + (b) * 2 + (h)) * HTB)
#define PG8_STAGE(bufoff, gbase, voff) do { _Pragma("unroll") for (int _i = 0; _i < 2; ++_i) \
        __builtin_amdgcn_global_load_lds((const unsigned*)((const char*)(gbase) + (voff)[_i]), (PG8_LAS unsigned*)(lds + (bufoff) + ldsw + _i * 8192), 16, 0, 0); } while (0)
#define PG8_LDA(dst, b, h) do { _Pragma("unroll") for (int m = 0; m < 4; ++m) _Pragma("unroll") for (int k = 0; k < 2; ++k) dst[m][k] = *(const PG8_LAS bf16x8*)(lds + PG8_SA(b, h) + aoff + m * 2048 + k * 1024); } while (0)
#define PG8_LDB(dst, b, h) do { _Pragma("unroll") for (int n = 0; n < 2; ++n) _Pragma("unroll") for (int k = 0; k < 2; ++k) dst[n][k] = *(const PG8_LAS bf16x8*)(lds + PG8_SB(b, h) + boff + n * 2048 + k * 1024); } while (0)
#define PG8_MMA(ai, bj, At, Bt) do { __builtin_amdgcn_s_setprio(1); _Pragma("unroll") for (int m = 0; m < 4; ++m) _Pragma("unroll") for (int n = 0; n < 2; ++n) _Pragma("unroll") for (int k = 0; k < 2; ++k) \
        acc[ai][bj][m][n] = __builtin_amdgcn_mfma_f32_16x16x32_bf16(Bt[n][k], At[m][k], acc[ai][bj][m][n], 0, 0, 0); __builtin_amdgcn_s_setprio(0); } while (0)
#define PG8_WAIT_V(n) asm volatile("s_waitcnt vmcnt(" #n ")" ::: "memory")
#define PG8_WAIT_L(n) asm volatile("s_waitcnt lgkmcnt(" #n ")" ::: "memory")
#define PG8_BAR __builtin_amdgcn_s_barrier()
#define PG8_SCHED __builtin_amdgcn_sched_barrier(0)
    Unit cur, nxt; int ui = 0;
    if (!S.next(0, cur)) return;
    f32x4 acc[2][2][4][2];
#pragma unroll
    for (int a = 0; a < 2; ++a)
#pragma unroll
        for (int b = 0; b < 2; ++b)
#pragma unroll
            for (int m = 0; m < 4; ++m)
#pragma unroll
                for (int n = 0; n < 2; ++n) acc[a][b][m][n] = (f32x4){0.f, 0.f, 0.f, 0.f};
    bf16x8 At[4][2], B0[2][2], B1[2][2];
    const char* cA = (const char*)g.A + (size_t)cur.pm * tstep; const char* cB = (const char*)g.Bt + (size_t)cur.pn * tstep;
    S.a_ready(cur);
    if constexpr (SP2) {
        PG8_STAGE(PG8_SB(0, 0), cB, voffB); PG8_STAGE(PG8_SB(0, 1), cB + hstep, voffB); PG8_STAGE(PG8_SA(0, 0), cA, voffA); PG8_STAGE(PG8_SA(0, 1), cA + hstep, voffA);
        if (wr == 1) PG8_BAR;
        PG8_WAIT_V(2); PG8_BAR;
        PG8_STAGE(PG8_SB(1, 0), cB + kstep, voffB); PG8_STAGE(PG8_SA(1, 0), cA + kstep, voffA); PG8_STAGE(PG8_SB(1, 1), cB + hstep + kstep, voffB);
        PG8_WAIT_V(6); PG8_BAR;
    } else {
        PG8_STAGE(PG8_SB(0, 0), cB, voffB); PG8_STAGE(PG8_SA(0, 0), cA, voffA); PG8_STAGE(PG8_SB(0, 1), cB + hstep, voffB); PG8_STAGE(PG8_SA(0, 1), cA + hstep, voffA);
        if (wr == 1) PG8_BAR;
        PG8_WAIT_V(4); PG8_BAR;
        PG8_STAGE(PG8_SB(1, 0), cB + kstep, voffB); PG8_STAGE(PG8_SA(1, 0), cA + kstep, voffA); PG8_STAGE(PG8_SB(1, 1), cB + hstep + kstep, voffB);
        PG8_WAIT_V(6); PG8_BAR;
    }
    for (;;) {
        const bool has_next = S.next(ui + 1, nxt);
        const char* nA = has_next ? (const char*)g.A + (size_t)nxt.pm * tstep : cA; const char* nB = has_next ? (const char*)g.Bt + (size_t)nxt.pn * tstep : cB;
        for (int t = 0; t < nt; t += 2) {
            const bool last = (t == nt - 2);
            const char* a1 = cA + (size_t)(t + 1) * kstep;
            const char* a2 = last ? nA : cA + (size_t)(t + 2) * kstep; const char* b2 = last ? nB : cB + (size_t)(t + 2) * kstep;
            const char* a3 = a2 + kstep; const char* b3 = b2 + kstep;
            if (last && has_next) S.a_ready(nxt);
            if constexpr (SP2) {
            PG8_LDB(B0, 0, 0); PG8_LDB(B1, 0, 1); PG8_SCHED; PG8_LDA(At, 0, 0); PG8_STAGE(PG8_SA(1, 1), a1 + hstep, voffA);
            PG8_WAIT_V(8); PG8_WAIT_L(0); PG8_BAR; PG8_MMA(0, 0, At, B0); PG8_MMA(0, 1, At, B1); PG8_BAR; PG8_SCHED;
            PG8_LDA(At, 0, 1); PG8_STAGE(PG8_SB(0, 0), b2, voffB); PG8_STAGE(PG8_SB(0, 1), b2 + hstep, voffB); PG8_STAGE(PG8_SA(0, 0), a2, voffA);
            PG8_WAIT_V(8); PG8_WAIT_L(0); PG8_BAR; PG8_MMA(1, 0, At, B0); PG8_MMA(1, 1, At, B1); PG8_BAR; PG8_SCHED;
            PG8_LDB(B0, 1, 0); PG8_LDB(B1, 1, 1); PG8_SCHED; PG8_LDA(At, 1, 0); PG8_STAGE(PG8_SA(0, 1), a2 + hstep, voffA);
            PG8_WAIT_V(8); PG8_WAIT_L(0); PG8_BAR; PG8_MMA(0, 0, At, B0); PG8_MMA(0, 1, At, B1); PG8_BAR; PG8_SCHED;
            PG8_LDA(At, 1, 1); PG8_STAGE(PG8_SB(1, 0), b3, voffB); PG8_STAGE(PG8_SB(1, 1), b3 + hstep, voffB); PG8_STAGE(PG8_SA(1, 0), a3, voffA);
            PG8_WAIT_V(8); PG8_WAIT_L(0); PG8_BAR; PG8_MMA(1, 0, At, B0); PG8_MMA(1, 1, At, B1); PG8_BAR; PG8_SCHED;
            } else {
            PG8_LDB(B0, 0, 0); PG8_SCHED; PG8_LDA(At, 0, 0); PG8_STAGE(PG8_SA(1, 1), a1 + hstep, voffA);
            PG8_WAIT_L(8); PG8_BAR; PG8_WAIT_L(0); PG8_MMA(0, 0, At, B0); PG8_BAR; PG8_SCHED;
            PG8_LDB(B1, 0, 1); PG8_STAGE(PG8_SB(0, 0), b2, voffB);
            PG8_BAR; PG8_WAIT_L(0); PG8_MMA(0, 1, At, B1); PG8_BAR;
            PG8_LDA(At, 0, 1); PG8_STAGE(PG8_SA(0, 0), a2, voffA);
            PG8_BAR; PG8_WAIT_L(0); PG8_MMA(1, 0, At, B0); PG8_BAR; PG8_SCHED;
            PG8_STAGE(PG8_SB(0, 1), b2 + hstep, voffB);
            PG8_WAIT_V(6); PG8_BAR; PG8_MMA(1, 1, At, B1); PG8_BAR;
            PG8_LDB(B0, 1, 0); PG8_SCHED; PG8_LDA(At, 1, 0); PG8_STAGE(PG8_SA(0, 1), a2 + hstep, voffA);
            PG8_WAIT_L(8); PG8_BAR; PG8_WAIT_L(0); PG8_MMA(0, 0, At, B0); PG8_BAR; PG8_SCHED;
            PG8_LDB(B1, 1, 1); PG8_STAGE(PG8_SB(1, 0), b3, voffB);
            PG8_BAR; PG8_WAIT_L(0); PG8_MMA(0, 1, At, B1); PG8_BAR;
            PG8_LDA(At, 1, 1); PG8_STAGE(PG8_SA(1, 0), a3, voffA);
            PG8_BAR; PG8_WAIT_L(0); PG8_MMA(1, 0, At, B0); PG8_BAR; PG8_SCHED;
            PG8_STAGE(PG8_SB(1, 1), b3 + hstep, voffB);
            PG8_WAIT_V(6); PG8_BAR; PG8_MMA(1, 1, At, B1); PG8_BAR;
            }
        }
        if constexpr (ALIGN_EPI) { if (wr == 0) PG8_BAR; }
        if constexpr (!Epi::AFTER_DRAIN) { E(acc, cur, wr, wc, fr, fq); S.done(cur); }
        if (!has_next) break;
#pragma unroll
        for (int a = 0; a < 2; ++a)
#pragma unroll
            for (int b = 0; b < 2; ++b)
#pragma unroll
                for (int m = 0; m < 4; ++m)
#pragma unroll
                    for (int n = 0; n < 2; ++n) acc[a][b][m][n] = (f32x4){0.f, 0.f, 0.f, 0.f};
        cur = nxt; cA = nA; cB = nB; ++ui;
        if constexpr (ALIGN_EPI) { if (wr == 1) PG8_BAR; }
    }
    PG8_WAIT_V(0);
    if constexpr (!ALIGN_EPI) { if (wr == 0) PG8_BAR; }
    PG8_BAR;
    if constexpr (Epi::AFTER_DRAIN) { E.fused(acc, cur, wr, wc, fr, fq, lds, wid, lane); S.done(cur); }
#undef PG8_SA
#undef PG8_SB
#undef PG8_STAGE
#undef PG8_LDA
#undef PG8_LDB
#undef PG8_MMA
#undef PG8_WAIT_V
#undef PG8_WAIT_L
#undef PG8_BAR
#undef PG8_SCHED
}
}

#ifndef PG8_SP2
#define PG8_SP2 true
#endif
#ifndef PG8_ALIGN
#define PG8_ALIGN true
#endif
#include <hip/hip_bf16.h>
#include <cmath>
namespace attn_body {
using bf16=__hip_bfloat16;
using bf16x8=__attribute__((ext_vector_type(8)))short;
using s16x4=__attribute__((ext_vector_type(4)))short;
using f32x16=__attribute__((ext_vector_type(16)))float;
using u32x4=__attribute__((ext_vector_type(4)))unsigned;
constexpr int D=64;
constexpr int NW=8,QBLK=32,QB=QBLK*NW,KVBLK=64;
constexpr int ATTN_UNIT_ROWS=QB;
__device__ __forceinline__ int crow(int r,int hi){return (r&3)+8*(r>>2)+4*hi;}
#define SBAR() __builtin_amdgcn_sched_barrier(0)
__device__ __forceinline__ void cmask(f32x16&p0,f32x16&p1,int jb,int qrel,int hi){
  const float NEG=-INFINITY; int kb=64*jb+4*hi;
  #pragma unroll
  for(int r=0;r<16;++r){int kv=kb+(r&3)+8*(r>>2); if(kv>qrel)p0[r]=NEG; if(kv+32>qrel)p1[r]=NEG;}
}

__device__ __forceinline__ void wmask(f32x16&p0,f32x16&p1,unsigned long long w,int hi){
  const unsigned wl=((unsigned)w)>>(4*hi), wh=((unsigned)(w>>32))>>(4*hi);
  #pragma unroll
  for(int r=0;r<16;++r){ const int pr=(r&3)+8*(r>>2);
    const unsigned m0=(unsigned)(((int)(wl<<(31-pr)))>>31), m1=(unsigned)(((int)(wh<<(31-pr)))>>31);
    p0[r]=__uint_as_float((__float_as_uint(p0[r])&m0)|(0xFF800000u&~m0));
    p1[r]=__uint_as_float((__float_as_uint(p1[r])&m1)|(0xFF800000u&~m1)); }
}
constexpr int NSLOT=3, SLOTB=8192;
constexpr int LDS_K=0, LDS_V=NSLOT*SLOTB, LDS_WS=2*NSLOT*SLOTB, LDS_OST=LDS_WS+NW*64*4, LDS_BYTES=LDS_OST+NW*4096;
constexpr float C2=0.125f*1.4426950408889634f;
__device__ __forceinline__ void glds16(const void*gsrc,unsigned lds_dst){unsigned keep;
  asm volatile("s_mov_b32 %0, m0\n\ts_mov_b32 m0, %2\n\ts_nop 0\n\tglobal_load_lds_dwordx4 %1, off\n\ts_mov_b32 m0, %0":"=&s"(keep):"v"(gsrc),"s"(lds_dst):"memory");}
__device__ __forceinline__ float max3f(float a,float b,float c){float r;asm("v_max3_f32 %0, %1, %2, %3":"=v"(r):"v"(a),"v"(b),"v"(c));return r;}
__device__ __forceinline__ float max2f(float a,float b){float r;asm("v_max_f32_e32 %0, %1, %2":"=v"(r):"v"(a),"v"(b));return r;}
__device__ __forceinline__ float fadd_s(float a,float b){float r;asm("v_add_f32_e32 %0, %1, %2":"=v"(r):"v"(a),"v"(b));return r;}
__device__ __forceinline__ float fsub_s(float a,float b){float r;asm("v_sub_f32_e32 %0, %1, %2":"=v"(r):"v"(a),"v"(b));return r;}
typedef float f32x2_t __attribute__((ext_vector_type(2))); typedef __bf16 bf16x2_t __attribute__((ext_vector_type(2)));
__device__ __forceinline__ unsigned cvtpk_s(float lo,float hi){f32x2_t v={lo,hi};bf16x2_t b=__builtin_convertvector(v,bf16x2_t);return __builtin_bit_cast(unsigned,b);}
#define WAIT_BAR(N) asm volatile("s_waitcnt vmcnt(" #N ") lgkmcnt(0)\n\ts_barrier":::"memory")

__device__ __forceinline__ void qkt(f32x16&p0,f32x16&p1,const char*Kslot,const bf16x8*qr,const f32x16&negm,int r32,int hi){
  const char*kb=Kslot+hi*1024+r32*16;
  #pragma unroll
  for(int d0=0;d0<4;++d0){
    const bf16x8 b0=*reinterpret_cast<const bf16x8*>(kb+d0*2048);
    const bf16x8 b1=*reinterpret_cast<const bf16x8*>(kb+d0*2048+512);
    if(d0==0){p0=__builtin_amdgcn_mfma_f32_32x32x16_bf16(b0,qr[0],negm,0,0,0);p1=__builtin_amdgcn_mfma_f32_32x32x16_bf16(b1,qr[0],negm,0,0,0);}
    else{p0=__builtin_amdgcn_mfma_f32_32x32x16_bf16(b0,qr[d0],p0,0,0,0);p1=__builtin_amdgcn_mfma_f32_32x32x16_bf16(b1,qr[d0],p1,0,0,0);}}
}
typedef __attribute__((address_space(3))) const char* lds_cptr;
typedef short v4i16_t __attribute__((ext_vector_type(4)));
__device__ __forceinline__ void kload8(bf16x8*kf,lds_cptr kp){
  kf[0]=*(const __attribute__((address_space(3))) bf16x8*)(kp);      kf[1]=*(const __attribute__((address_space(3))) bf16x8*)(kp+512);
  kf[2]=*(const __attribute__((address_space(3))) bf16x8*)(kp+2048); kf[3]=*(const __attribute__((address_space(3))) bf16x8*)(kp+2560);
  kf[4]=*(const __attribute__((address_space(3))) bf16x8*)(kp+4096); kf[5]=*(const __attribute__((address_space(3))) bf16x8*)(kp+4608);
  kf[6]=*(const __attribute__((address_space(3))) bf16x8*)(kp+6144); kf[7]=*(const __attribute__((address_space(3))) bf16x8*)(kp+6656);
}
__device__ __forceinline__ void kload2(bf16x8*kf,lds_cptr kp,int j){ kf[2*j]=*(const __attribute__((address_space(3))) bf16x8*)(kp+j*2048); kf[2*j+1]=*(const __attribute__((address_space(3))) bf16x8*)(kp+j*2048+512); }
__device__ __forceinline__ s16x4 vtr(lds_cptr p){ return __builtin_bit_cast(s16x4,__builtin_amdgcn_ds_read_tr16_b64_v4i16((__attribute__((address_space(3))) v4i16_t*)p)); }
__device__ __forceinline__ float rowmax(const f32x16&p0,const f32x16&p1){
  float a=max3f(p0[0],p0[1],p1[0]),b=max3f(p0[2],p0[3],p1[1]);a=max3f(a,p1[2],p1[3]);
  #pragma unroll
  for(int r=4;r<16;r+=4){a=max3f(a,p0[r],p0[r+1]);b=max3f(b,p0[r+2],p0[r+3]);a=max3f(a,p1[r],p1[r+1]);b=max3f(b,p1[r+2],p1[r+3]);}
  const float m=max2f(a,b);
  auto rr=__builtin_amdgcn_permlane32_swap(__float_as_uint(m),__float_as_uint(m),false,false);
  return max2f(__uint_as_float(rr[0]),__uint_as_float(rr[1]));
}
__device__ __forceinline__ void pv(f32x16*o,int vb,bf16x8 pa0,bf16x8 pa1,bf16x8 pa2,bf16x8 pa3){
  #pragma unroll
  for(int d0=0;d0<2;++d0){s16x4 lo[4],hi[4];
    #pragma unroll
    for(int ks=0;ks<4;++ks){
      asm volatile("ds_read_b64_tr_b16 %0,%1 offset:%c2":"=&v"(lo[ks]):"v"(vb),"i"(d0*4096+ks*1024):"memory");
      asm volatile("ds_read_b64_tr_b16 %0,%1 offset:%c2":"=&v"(hi[ks]):"v"(vb),"i"(d0*4096+ks*1024+512):"memory");}
    asm volatile("s_waitcnt lgkmcnt(0)":::"memory");SBAR();
    #define PK(k) (bf16x8){lo[k][0],lo[k][1],lo[k][2],lo[k][3],hi[k][0],hi[k][1],hi[k][2],hi[k][3]}
    o[d0]=__builtin_amdgcn_mfma_f32_32x32x16_bf16(pa0,PK(0),o[d0],0,0,0);
    o[d0]=__builtin_amdgcn_mfma_f32_32x32x16_bf16(pa1,PK(1),o[d0],0,0,0);
    o[d0]=__builtin_amdgcn_mfma_f32_32x32x16_bf16(pa2,PK(2),o[d0],0,0,0);
    o[d0]=__builtin_amdgcn_mfma_f32_32x32x16_bf16(pa3,PK(3),o[d0],0,0,0);
    #undef PK
  }
}

#ifndef ATTN_STORE16
#define ATTN_STORE16(p,v) (*(u32x4*)(p)=(v))
#endif
template<int THRL,bool MASKED,int PQ,int PV,int PO,int SEQ> __device__ __forceinline__ void attn_unit(int b,int qcol,int vcol,int ocol,int qb,const bf16*Q,const bf16*__restrict__ K,const bf16*__restrict__ V,bf16*O,const unsigned long long*__restrict__ Wm,char*shm,const int tid){
  const int lane=tid&63,r32=lane&31,hi=lane>>5; const int wid=__builtin_amdgcn_readfirstlane(tid>>6);
  const long rowbase=(long)b*SEQ; const int q0=qb*QB;
  const bf16*Qw=Q+(rowbase+q0+wid*QBLK)*PQ+qcol;
  const bf16*Kh=K+rowbase*PQ+qcol,*Vh=V+rowbase*PV+vcol;
  const unsigned long long*Wrow=Wm+(rowbase+q0+wid*QBLK+r32)*64;
  const unsigned lds0=(unsigned)(uintptr_t)shm;
  float*wsf=(float*)(shm+LDS_WS)+wid*64;
  const bf16*ksrc=Kh+(long)lane*PQ+wid*8;
  const bf16*vsrc=Vh+(long)(16*(wid&3)+(lane>>2))*PV+(wid>>2)*32+(lane&3)*8;
  const unsigned kdst=lds0+LDS_K+wid*1024, vdst=lds0+LDS_V+wid*1024;
  #define DMA_K(t,slot) glds16(ksrc+(long)(t)*KVBLK*PQ,(unsigned)__builtin_amdgcn_readfirstlane(kdst+(slot)))
  #define DMA_V(t,slot) glds16(vsrc+(long)(t)*KVBLK*PV,(unsigned)__builtin_amdgcn_readfirstlane(vdst+(slot)))
  const int vb0=(int)(lds0+LDS_V)+((lane>>4)&1)*32+(lane&3)*8+(4*hi+((lane&15)>>2))*64;
  const char*Kbase=shm+LDS_K; bf16x8 kf[8];
  const lds_cptr shm3=(lds_cptr)shm; const lds_cptr kp0=shm3+LDS_K+hi*1024+r32*16; const lds_cptr vp0=shm3+LDS_V+((lane>>4)&1)*32+(lane&3)*8+(4*hi+((lane&15)>>2))*64;
  const int NT=(q0+QB)/KVBLK;
  DMA_K(0,0);DMA_V(0,0);DMA_K(1,SLOTB);
  bf16x8 qr[4];
  #pragma unroll
  for(int d0=0;d0<4;++d0)qr[d0]=*reinterpret_cast<const bf16x8*>(&Qw[(long)r32*PQ+d0*16+hi*8]);
  float mhat=0.f,l_reg=0.f;f32x16 o[2];o[0]=f32x16{};o[1]=f32x16{};const f32x16 zz=f32x16{};
  const int qrel=wid*QBLK+r32;
  #define CMASK(P0,P1,t) do{ if(MASKED){ wmask(P0,P1,wcur,hi); } else { int jb_=(t)-(NT-4); if(jb_>=0)cmask(P0,P1,jb_,qrel,hi); } }while(0)
  bool resc=false;
  #define START(P0,P1) do{ const float rm=rowmax(P0,P1); resc=false; \
    { const float dl=(MASKED&&rm==-INFINITY)?0.f:rm; mhat=fadd_s(mhat,dl); \
      _Pragma("unroll") for(int r=0;r<16;++r){P0[r]=fsub_s(P0[r],dl);P1[r]=fsub_s(P1[r],dl);} \
      } \
    _Pragma("unroll") for(int r=0;r<16;++r)P0[r]=__builtin_amdgcn_exp2f(P0[r]); }while(0)
  #define RESC() do{ if(resc){ asm volatile("s_waitcnt lgkmcnt(0)":::"memory"); \
      _Pragma("unroll") for(int d_=0;d_<2;++d_) _Pragma("unroll") for(int r=0;r<16;++r)o[d_][r]*=wsf[crow(r,hi)]; } }while(0)
  f32x16 pA0,pA1,pB0,pB1;
  int sl_prev=0,sl_cur=0,sl_next=SLOTB;
  #define ROT() do{sl_prev=sl_cur;sl_cur=sl_next;sl_next=(sl_next==(NSLOT-1)*SLOTB)?0:sl_next+SLOTB;}while(0)
  DMA_K(2,2*SLOTB);
  WAIT_BAR(3);
  { unsigned long long wcur=0ull; if(MASKED)wcur=Wrow[0];
    qkt(pA0,pA1,Kbase,qr,zz,r32,hi);asm volatile("s_nop 15\n\ts_nop 7":"+v"(pA0),"+v"(pA1));CMASK(pA0,pA1,0); }
  START(pA0,pA1);
  _Pragma("unroll") for(int r=0;r<16;++r)pA1[r]=__builtin_amdgcn_exp2f(pA1[r]);
  WAIT_BAR(0);
  DMA_K(3,0);DMA_V(1,SLOTB);
  ROT();
  kload8(kf,kp0+sl_cur);
  WAIT_BAR(2);
  s16x4 vlo[8],vhi[8]; u32x4 pw0,pw1,pw2,pw3;
  #define PKW(P,B) cvtpk_s(P[B],P[B+1])
  #define PAF(k) __builtin_bit_cast(bf16x8,pw##k)
  #define VFR(i) (bf16x8){vlo[i][0],vlo[i][1],vlo[i][2],vlo[i][3],vhi[i][0],vhi[i][1],vhi[i][2],vhi[i][3]}
  #define PIN(x) asm volatile("":"+v"(x))
  #define MX3(a,b,c) __builtin_fmaxf(__builtin_fmaxf((a),(b)),(c))
  #define GAPA(MF,A0,A1,A2,A3,W0,W1,PW) do{ MF; sacc+=A0; sacc+=A1; sacc+=A2; sacc+=A3; PIN(sacc); W0; W1; PIN(PW); SBAR(); }while(0)
  #define EX(v) __builtin_amdgcn_exp2f(v)
  #define GAPB(MF,X,B) do{ MF; X[B]=EX(X[B]-mhat); X[B+1]=EX(X[B+1]-mhat); X[B+2]=EX(X[B+2]-mhat); X[B+3]=EX(X[B+3]-mhat); PIN(X); SBAR(); }while(0)
  #define VRD(i) do{ vlo[i]=vtr(vp_+(((i)>>2)*4096+((i)&3)*1024)); vhi[i]=vtr(vp_+(((i)>>2)*4096+((i)&3)*1024+512)); }while(0)
  #define KRD(G,j) do{ if(G){ kload2(kf,kp0+sl_next,j); SBAR(); } }while(0)
  #define STEP(C0,C1,P0,P1,t,GK,GV,GL) do{ SBAR(); \
    unsigned long long wcur=0ull; if(MASKED){ wcur=Wrow[(t)]; SBAR(); } \
    const lds_cptr vp_=vp0+sl_prev; \
    VRD(0); SBAR(); float sacc=(P0[0]+P0[1]); \
    GAPA(C0=__builtin_amdgcn_mfma_f32_32x32x16_bf16(kf[0],qr[0],zz,0,0,0), P0[2],P0[3],P0[4],P0[5],     pw0[0]=PKW(P0,0), pw0[1]=PKW(P0,2), pw0); \
    VRD(4); SBAR(); GAPA(C1=__builtin_amdgcn_mfma_f32_32x32x16_bf16(kf[1],qr[0],zz,0,0,0), P0[6],P0[7],P0[8],P0[9],     pw0[2]=PKW(P0,4), pw0[3]=PKW(P0,6), pw0); \
    VRD(1); SBAR(); GAPA(C0=__builtin_amdgcn_mfma_f32_32x32x16_bf16(kf[2],qr[1],C0,0,0,0),   P0[10],P0[11],P0[12],P0[13], pw1[0]=PKW(P0,8), pw1[1]=PKW(P0,10), pw1); \
    VRD(5); SBAR(); GAPA(C1=__builtin_amdgcn_mfma_f32_32x32x16_bf16(kf[3],qr[1],C1,0,0,0),   P0[14],P0[15],P1[0],P1[1],   pw1[2]=PKW(P0,12),pw1[3]=PKW(P0,14), pw1); \
    VRD(2); SBAR(); GAPA(C0=__builtin_amdgcn_mfma_f32_32x32x16_bf16(kf[4],qr[2],C0,0,0,0),   P1[2],P1[3],P1[4],P1[5],     pw2[0]=PKW(P1,0), pw2[1]=PKW(P1,2), pw2); \
    VRD(6); SBAR(); GAPA(C1=__builtin_amdgcn_mfma_f32_32x32x16_bf16(kf[5],qr[2],C1,0,0,0),   P1[6],P1[7],P1[8],P1[9],     pw2[2]=PKW(P1,4), pw2[3]=PKW(P1,6), pw2); \
    VRD(3); SBAR(); GAPA(C0=__builtin_amdgcn_mfma_f32_32x32x16_bf16(kf[6],qr[3],C0,0,0,0),   P1[10],P1[11],P1[12],P1[13], pw3[0]=PKW(P1,8), pw3[1]=PKW(P1,10), pw3); \
    VRD(7); SBAR(); GAPA(C1=__builtin_amdgcn_mfma_f32_32x32x16_bf16(kf[7],qr[3],C1,0,0,0),   P1[14],P1[15],0.f,0.f,       pw3[2]=PKW(P1,12),pw3[3]=PKW(P1,14), pw3); \
    l_reg+=sacc; \
    if(!MASKED){ if(GK){DMA_K((t)+3,sl_cur);} if(GV){DMA_V((t)+1,sl_next);} } \
    CMASK(C0,C1,t); \
    if(MASKED){ if(GK){DMA_K((t)+3,sl_cur);} if(GV){DMA_V((t)+1,sl_next);} } \
    { float a=MX3(C0[0],C0[1],C1[0]),b=MX3(C0[2],C0[3],C1[1]); a=MX3(a,C1[2],C1[3]); \
      _Pragma("unroll") for(int r=4;r<16;r+=4){a=MX3(a,C0[r],C0[r+1]);b=MX3(b,C0[r+2],C0[r+3]);a=MX3(a,C1[r],C1[r+1]);b=MX3(b,C1[r+2],C1[r+3]);} \
      float rm=__builtin_fmaxf(a,b); { auto rr=__builtin_amdgcn_permlane32_swap(__float_as_uint(rm),__float_as_uint(rm),false,false); rm=__builtin_fmaxf(__uint_as_float(rr[0]),__uint_as_float(rr[1])); } \
      rm-=mhat; resc=false; \
      if(__builtin_expect(__any(rm>(float)THRL),0)){ const float dl=__builtin_fmaxf(rm,0.f); mhat+=dl; \
        const float f=__builtin_amdgcn_exp2f(-dl); l_reg*=f; if(hi==0)wsf[r32]=f; resc=true; } } \
    SBAR(); \
    GAPB(o[0]=__builtin_amdgcn_mfma_f32_32x32x16_bf16(PAF(0),VFR(0),o[0],0,0,0), C0,0); \
    GAPB(o[1]=__builtin_amdgcn_mfma_f32_32x32x16_bf16(PAF(0),VFR(4),o[1],0,0,0), C0,4); \
    KRD(GL,0); GAPB(o[0]=__builtin_amdgcn_mfma_f32_32x32x16_bf16(PAF(1),VFR(1),o[0],0,0,0), C0,8); \
    KRD(GL,1); GAPB(o[1]=__builtin_amdgcn_mfma_f32_32x32x16_bf16(PAF(1),VFR(5),o[1],0,0,0), C0,12); \
    KRD(GL,2); GAPB(o[0]=__builtin_amdgcn_mfma_f32_32x32x16_bf16(PAF(2),VFR(2),o[0],0,0,0), C1,0); \
    KRD(GL,3); GAPB(o[1]=__builtin_amdgcn_mfma_f32_32x32x16_bf16(PAF(2),VFR(6),o[1],0,0,0), C1,4); \
    GAPB(o[0]=__builtin_amdgcn_mfma_f32_32x32x16_bf16(PAF(3),VFR(3),o[0],0,0,0), C1,8); \
    GAPB(o[1]=__builtin_amdgcn_mfma_f32_32x32x16_bf16(PAF(3),VFR(7),o[1],0,0,0), C1,12); \
    }while(0)
  int t=1;
  #undef CMASK
  #define CMASK(P0,P1,t) do{ if(MASKED){ wmask(P0,P1,wcur,hi); } }while(0)
  for(;t+5<NT;t+=2){
    STEP(pB0,pB1,pA0,pA1,t,true,true,true);     WAIT_BAR(2); RESC(); ROT();
    STEP(pA0,pA1,pB0,pB1,t+1,true,true,true);   WAIT_BAR(2); RESC(); ROT();
  }
  #undef CMASK
  #define CMASK(P0,P1,t) do{ if(MASKED){ wmask(P0,P1,wcur,hi); } else { int jb_=(t)-(NT-4); if(jb_>=0)cmask(P0,P1,jb_,qrel,hi); } }while(0)
  #define ENDW(tt) do{ if((tt)+3<NT){WAIT_BAR(2);} else if((tt)+2<NT){WAIT_BAR(1);} else {WAIT_BAR(0);} }while(0)
  for(;t+1<NT;t+=2){
    STEP(pB0,pB1,pA0,pA1,t,(t+3<NT),(t+1<NT),(t+1<NT));       ENDW(t);   RESC(); ROT();
    STEP(pA0,pA1,pB0,pB1,t+1,(t+4<NT),(t+2<NT),(t+2<NT));     ENDW(t+1); RESC(); ROT();
  }
  STEP(pB0,pB1,pA0,pA1,NT-1,false,false,false); RESC();
  { float sacc=pB0[0]+pB0[1]; _Pragma("unroll") for(int r=2;r<16;++r)sacc+=pB0[r]; _Pragma("unroll") for(int r=0;r<16;++r)sacc+=pB1[r]; l_reg+=sacc;
    pw0=(u32x4){PKW(pB0,0),PKW(pB0,2),PKW(pB0,4),PKW(pB0,6)};pw1=(u32x4){PKW(pB0,8),PKW(pB0,10),PKW(pB0,12),PKW(pB0,14)};pw2=(u32x4){PKW(pB1,0),PKW(pB1,2),PKW(pB1,4),PKW(pB1,6)};pw3=(u32x4){PKW(pB1,8),PKW(pB1,10),PKW(pB1,12),PKW(pB1,14)};
    SBAR(); pv(o,vb0+sl_cur,PAF(0),PAF(1),PAF(2),PAF(3)); }
  #undef PKW
  #undef PAF
  #undef VFR
  #undef PIN
  #undef MX3
  #undef GAPA
  #undef GAPB
  #undef EX
  #undef VRD
  #undef KRD
  #undef STEP
  #undef ENDW
  {auto rr=__builtin_amdgcn_permlane32_swap(__float_as_uint(l_reg),__float_as_uint(l_reg),false,false);l_reg=__uint_as_float(rr[0])+__uint_as_float(rr[1]);}
  if(hi==0)wsf[32+r32]=l_reg;asm volatile("s_waitcnt lgkmcnt(0)":::"memory");
  float rli[16];
  #pragma unroll
  for(int r=0;r<16;++r)rli[r]=__builtin_amdgcn_rcpf(wsf[32+crow(r,hi)]);
  bf16*Ow=O+(rowbase+q0+wid*QBLK)*PO+ocol;
  { bf16*stg=(bf16*)(shm+LDS_OST)+wid*2048;
    #pragma unroll
    for(int r=0;r<16;++r){const int orow=crow(r,hi);
      #pragma unroll
      for(int d0=0;d0<2;++d0)stg[orow*64+d0*32+r32]=__float2bfloat16(o[d0][r]*rli[r]);}
    asm volatile("s_waitcnt lgkmcnt(0)":::"memory");
    #pragma unroll
    for(int i=0;i<4;++i){const int row=i*8+(lane>>3),ch=lane&7; const u32x4 v=*(const u32x4*)(stg+row*64+ch*8); ATTN_STORE16(Ow+(long)row*PO+ch*8,v);} }
  asm volatile("s_waitcnt lgkmcnt(0)\n\ts_barrier":::"memory");
  #undef DMA_K
  #undef DMA_V
  #undef CMASK
  #undef START
  #undef RESC
  #undef ROT
}
constexpr int ATTN_LDS_BYTES=LDS_BYTES;
struct AttnTensors { const bf16* Q; const bf16* K; const bf16* V; bf16* O; const unsigned long long* W; };
struct AttnUnit { int b, qcol, vcol, ocol, qb; };
struct DiffOrder {
  int vcu;
  __device__ __forceinline__ explicit DiffOrder(int v):vcu(v){}
  __device__ __forceinline__ bool next(int i,AttnUnit&u)const{ if(i>=4)return false; const int st=vcu>>2,s=vcu&3,hc=(st>>1)&7,half=st&1;
    u.b=st>>4; u.qcol=hc*64; u.vcol=(hc>>1)*128+half*64; u.ocol=hc*128+half*64; u.qb=(i==0)?s:(i==1)?7-s:(i==2)?8+s:15-s; return true; }
};
struct DsaOrder {
  int vcu;
  __device__ __forceinline__ explicit DsaOrder(int v):vcu(v){}
  __device__ __forceinline__ bool next(int i,AttnUnit&u)const{ if(i>=2)return false; const int st=vcu>>3,s=vcu&7,h=st&7;
    u.b=st>>3; u.qcol=h*64; u.vcol=h*64; u.ocol=h*64; u.qb=(i==0)?s:15-s; return true; }
};
template<class Sched,bool MASKED,int PQ,int PV,int PO,int SEQ,int THRL=8> __device__ __forceinline__ void attn_phase(char*lds,const AttnTensors&T,const Sched&S,const int tid){
  AttnUnit u;
  for(int i=0;S.next(i,u);++i){ attn_unit<THRL,MASKED,PQ,PV,PO,SEQ>(u.b,u.qcol,u.vcol,u.ocol,u.qb,T.Q,T.K,T.V,T.O,T.W,lds,tid); }
}
#undef SBAR
#undef WAIT_BAR
}

#define GAS __attribute__((address_space(1)))
#define LAS __attribute__((address_space(3)))
typedef unsigned short bf16;
typedef unsigned v4u __attribute__((ext_vector_type(4)));
typedef float f32x4 __attribute__((ext_vector_type(4)));
typedef short bf16x8 __attribute__((ext_vector_type(8)));
typedef GAS unsigned gu32;
typedef GAS unsigned long long gu64;
#define RLX_AGENT __ATOMIC_RELAXED, __HIP_MEMORY_SCOPE_AGENT
#define LDS_WAIT() asm volatile("s_waitcnt lgkmcnt(0)" ::: "memory")
#define VM_WAIT() asm volatile("s_waitcnt vmcnt(0)" ::: "memory")
__device__ __forceinline__ unsigned long long rt() { return __builtin_amdgcn_s_memrealtime(); }
__device__ __forceinline__ unsigned f2bf(float f) { unsigned u = __builtin_bit_cast(unsigned, f); return (u + 0x7fffu + ((u >> 16) & 1u)) >> 16; }
__device__ __forceinline__ unsigned pk2(float lo, float hi) { return f2bf(lo) | (f2bf(hi) << 16); }

#define XB_TMO      128
#define XB_XCNT(j)  (256  + 64 * (j))
#define XB_XSUB(j)  (1280 + 64 * (j))
#define XB_XGEN(j)  (2304 + 64 * (j))
#define XB_TOP      3328
#define XB_TOPGEN   3392
#define XCD_BAR_WORDS 3456
#define XB_SPIN_CAP (1u << 18)

__device__ __forceinline__ unsigned xb_ld(unsigned* p)              { return __hip_atomic_load(p, __ATOMIC_RELAXED, __HIP_MEMORY_SCOPE_AGENT); }
__device__ __forceinline__ unsigned xb_add(unsigned* p, unsigned v) { return __hip_atomic_fetch_add(p, v, __ATOMIC_RELAXED, __HIP_MEMORY_SCOPE_AGENT); }
__device__ __forceinline__ unsigned xb_xcc_id() { return (unsigned)__builtin_amdgcn_s_getreg((3 << 11) | 20) & 0xFu; }
#define XB_SPIN(cond, bar) do { unsigned _sp = 0; while (cond) { __builtin_amdgcn_s_sleep(1); \
    if ((++_sp & 255u) == 0u) { if (xb_ld(&(bar)[XB_TMO])) break; if (_sp > XB_SPIN_CAP) { atomicAdd(&(bar)[XB_TMO], 1u); break; } } } } while (0)

struct XcdBarrier {
    unsigned* bar; unsigned x;
    volatile LAS unsigned* st;
};

__device__ __forceinline__ XcdBarrier xcd_barrier_post(unsigned* bar, volatile LAS unsigned* st, const int tid) {
    XcdBarrier b; b.bar = bar; b.x = xb_xcc_id(); b.st = st;
    if (tid == 0) (void)xb_add(&bar[XB_XCNT(b.x)], 1u);
    return b;
}
__device__ __forceinline__ void xcd_barrier_complete(unsigned* bar, unsigned x, unsigned& nloc, unsigned& nx) {
    const unsigned G = 256u;
    unsigned sum, cnt, mine, sp = 0u;
    for (;;) {
        sum = 0u; cnt = 0u; mine = 0u;
#pragma unroll
        for (unsigned j = 0; j < 16; ++j) { const unsigned c = xb_ld(&bar[XB_XCNT(j)]); sum += c; cnt += (c > 0u) ? 1u : 0u; mine = (j == x) ? c : mine; }
        if (sum == G) break;
        __builtin_amdgcn_s_sleep(1);
        if ((++sp & 255u) == 0u) { if (xb_ld(&bar[XB_TMO])) break; if (sp > XB_SPIN_CAP) { atomicAdd(&bar[XB_TMO], 1u); break; } }
    }
    nloc = mine > 0u ? mine : 1u; nx = cnt > 0u ? cnt : 1u;
}

__device__ __forceinline__ void xcd_barrier(const XcdBarrier& b, const int tid) {
    asm volatile("s_waitcnt vmcnt(0)" ::: "memory");
    __syncthreads();
    if (tid == 0) {
        unsigned* bar = b.bar;
        __builtin_amdgcn_s_waitcnt(0);
        unsigned nloc = b.st[0], nx = b.st[1];
        if (nloc == 0u) { xcd_barrier_complete(bar, b.x, nloc, nx); b.st[0] = nloc; b.st[1] = nx; }
        const unsigned old = xb_add(&bar[XB_XSUB(b.x)], 1u);
        const unsigned gen = old / nloc;
        if (old + 1u == (gen + 1u) * nloc) {
            __builtin_amdgcn_fence(__ATOMIC_RELEASE, "agent");
            asm volatile("s_waitcnt vmcnt(0)" ::: "memory");
            const unsigned og = xb_add(&bar[XB_TOP], 1u);
            const unsigned tg = og / nx;
            if (og + 1u == (tg + 1u) * nx) xb_add(&bar[XB_TOPGEN], 1u);
            else XB_SPIN(xb_ld(&bar[XB_TOPGEN]) == tg, bar);
            __builtin_amdgcn_fence(__ATOMIC_ACQUIRE, "agent");
            xb_add(&bar[XB_XGEN(b.x)], 1u);
            asm volatile("s_waitcnt vmcnt(0)" ::: "memory");
        } else {
            XB_SPIN(xb_ld(&bar[XB_XGEN(b.x)]) == gen, bar);
            __builtin_amdgcn_fence(__ATOMIC_ACQUIRE, "agent");
            asm volatile("s_waitcnt vmcnt(0)" ::: "memory");
        }
    }
    __syncthreads();
}
constexpr int NWAVES = 8, GRID = 256;
constexpr int BATCH = 4, SEQ = 4096, D = 1024, M = BATCH * SEQ, FF = 4096, INW = 3656, NIN = 3840, NMOD = 6 * D;
constexpr float C2 = 0.125f * 1.4426950408889634f;
constexpr size_t MiB = 1u << 20;
constexpr size_t WS_CTL = 0, CTL_ZERO_BYTES = 1 * MiB;
constexpr size_t WS_MOD = 1 * MiB;
constexpr size_t WS_WIN = 2 * MiB, WS_WOUT = 10 * MiB, WS_W1 = 12 * MiB, WS_W2 = 20 * MiB;
constexpr size_t WS_COS = 28 * MiB, WS_SIN = 30 * MiB;
constexpr size_t WS_QKV = 32 * MiB;
constexpr size_t WS_ODIFF = 144 * MiB;
constexpr size_t WS_MIX = 176 * MiB;
constexpr size_t WS_XN = 208 * MiB;
constexpr size_t WS_RAW = 240 * MiB, WS_IK = 245 * MiB, WS_IW = 247 * MiB;
constexpr size_t WS_WM = 248 * MiB;
constexpr size_t WS_H = 32 * MiB;
constexpr size_t WS_END = 256 * MiB;
static_assert(WS_H + (size_t)M * FF * 2 <= WS_MIX && WS_WM + (size_t)M * 64 * 8 <= WS_END && WS_RAW + (size_t)M * 80 * 4 <= WS_IK, "d_ws map");
constexpr int CW_BAR = 4096;
constexpr int RING_OFF = 0, RING_BYTES = 135168;
constexpr int LDSCTL_OFF = RING_BYTES, MISC_OFF = LDSCTL_OFF + 320;
constexpr int LDS_BYTES = 147456;
static_assert(MISC_OFF + 128 <= LDS_BYTES && pg8::STAGE_BYTES <= RING_BYTES && attn_body::ATTN_LDS_BYTES <= RING_BYTES, "LDS map");

struct Frame {
    LAS unsigned char* lds; volatile LAS unsigned* MISC; gu32* ctl;
    int tid, lane, wave, vcu, G;
};

__device__ __forceinline__ float wave_sum(float v) {
#pragma unroll
    for (int o = 1; o < 64; o <<= 1) v += __shfl_xor(v, o);
    return v;
}
__device__ __forceinline__ int wave_sum_i(int v) {
#pragma unroll
    for (int o = 1; o < 64; o <<= 1) v += __shfl_xor(v, o);
    return v;
}

__device__ __forceinline__ int unperm64(int p) { const int g = p >> 5, fq = (p >> 3) & 3, e = p & 7; return 16 * g + 4 * fq + (e & 3) + 32 * (e >> 2); }
__device__ __forceinline__ int perm64(int d) { const int half = d >> 5, j = d & 31; return 32 * (j >> 4) + 8 * ((j >> 2) & 3) + (j & 3) + 4 * half; }
__device__ __forceinline__ int orig_col(int c) {
    if (c < 2048) { if ((c >> 9) == 2) return c; return (c & ~63) + unperm64(c & 63); }
    if (c < 2304) { const int r = c - 2048; return r < 72 ? 2048 + r : -1; }
    const int cc = c - 2304; if ((cc >> 9) == 2) return 2120 + cc; return 2120 + (cc & ~63) + unperm64(cc & 63);
}

template <bool MAPPED>
__device__ __forceinline__ void p0_transpose_item(const float* W, int K, int N, int NP_, bf16* WT, LAS float* scr, int item, int lane) {
    const int nblk = NP_ / 32, kb = item / nblk, nb = item % nblk, k0 = 64 * kb, n0 = 32 * nb;
    const int src = MAPPED ? orig_col(n0 + (lane & 31)) : (n0 + (lane & 31));
#pragma unroll 8
    for (int i = 0; i < 32; ++i) { const int kk = 2 * i + (lane >> 5); scr[kk * 33 + (lane & 31)] = src >= 0 ? W[(size_t)(k0 + kk) * N + src] : 0.f; }
    LDS_WAIT(); asm volatile("" ::: "memory");
    const int c = lane & 7;
#pragma unroll
    for (int j = 0; j < 4; ++j) { const int n = (lane >> 3) + 8 * j; const LAS float* s = scr + (8 * c) * 33 + n;
        v4u o; o.x = pk2(s[0 * 33], s[1 * 33]); o.y = pk2(s[2 * 33], s[3 * 33]); o.z = pk2(s[4 * 33], s[5 * 33]); o.w = pk2(s[6 * 33], s[7 * 33]);
        *(GAS v4u*)(WT + (size_t)(n0 + n) * K + k0 + 8 * c) = o; }
    LDS_WAIT(); asm volatile("" ::: "memory");
}

struct Ptrs {
    const float *x, *c, *w_ada, *b_ada, *norm1_w, *w_in, *lnw, *lnb, *lq1, *lk1, *lq2, *lk2, *subln, *w_out, *norm2_w, *w_ff1, *w_ff2, *norm_f;
    const int* pos; float* out;
    float *mod, *cosT, *sinT, *raw, *iw;
    bf16 *Win, *Wout, *W1, *W2, *QKV, *ODIFF, *MIX, *XN, *IK, *H;
    unsigned long long* WM;
};

__device__ __forceinline__ void p0a(Frame& F, const Ptrs& P) {
    LAS float* sil = (LAS float*)(F.lds + RING_OFF);
    LAS float* red = (LAS float*)(F.lds + RING_OFF + 16384);
    for (int i = F.tid; i < 4096; i += NWAVES * 64) { const float v = P.c[i]; sil[i] = v / (1.f + __expf(-v)); }
    __syncthreads();
    for (int item = F.vcu; item < NMOD / 32; item += F.G) {
        const int jl = F.tid & 31, kp = F.tid >> 5, j = item * 32 + jl;
        float a0 = 0.f, a1 = 0.f, a2 = 0.f, a3 = 0.f;
#pragma unroll 8
        for (int k = kp; k < D; k += 16) { const float w = P.w_ada[(size_t)k * NMOD + j]; a0 += sil[k] * w; a1 += sil[1024 + k] * w; a2 += sil[2048 + k] * w; a3 += sil[3072 + k] * w; }
        red[(kp * 4 + 0) * 32 + jl] = a0; red[(kp * 4 + 1) * 32 + jl] = a1; red[(kp * 4 + 2) * 32 + jl] = a2; red[(kp * 4 + 3) * 32 + jl] = a3;
        __syncthreads();
        if (F.tid < 128) { const int b = F.tid >> 5; float s = 0.f;
#pragma unroll
            for (int q = 0; q < 16; ++q) s += red[(q * 4 + b) * 32 + jl];
            P.mod[b * NMOD + j] = s + P.b_ada[j]; }
        __syncthreads();
    }
    for (int e = F.vcu * (NWAVES * 64) + F.tid; e < M * 32; e += F.G * NWAVES * 64) {
        const int row = e >> 5, j = e & 31;
        const float inv = (float)pow(10000.0, -(double)j / 32.0);
        const float ang = (float)P.pos[row] * inv;
        P.cosT[e] = (float)cos((double)ang); P.sinT[e] = (float)sin((double)ang);
    }
    LAS float* scr = (LAS float*)(F.lds + RING_OFF + F.wave * 16384);
    const int gw = F.vcu * NWAVES + F.wave, NGW = F.G * NWAVES;
    constexpr int I_IN = (D / 64) * (NIN / 32), I_O = (D / 64) * (D / 32), I_1 = (D / 64) * (FF / 32), I_2 = (FF / 64) * (D / 32);
    constexpr int NITEMS = I_IN + I_O + I_1 + I_2;
    for (int it = gw; it < NITEMS; it += NGW) {
        int r = it;
        if (r < I_IN) { p0_transpose_item<true>(P.w_in, D, INW, NIN, P.Win, scr, r, F.lane); continue; } r -= I_IN;
        if (r < I_O) { p0_transpose_item<false>(P.w_out, D, D, D, P.Wout, scr, r, F.lane); continue; } r -= I_O;
        if (r < I_1) { p0_transpose_item<false>(P.w_ff1, D, FF, FF, P.W1, scr, r, F.lane); continue; } r -= I_1;
        p0_transpose_item<false>(P.w_ff2, FF, D, D, P.W2, scr, r, F.lane);
    }
}

__device__ __forceinline__ void mod_row(Frame& F, const float* xrow, bf16* orow, const float* nw, const float* sc, const float* sh) {
    const GAS f32x4* xr = (const GAS f32x4*)xrow + F.lane;
    f32x4 v[4]; float s = 0.f;
#pragma unroll
    for (int j = 0; j < 4; ++j) { v[j] = xr[64 * j]; s += (v[j].x * v[j].x + v[j].y * v[j].y) + (v[j].z * v[j].z + v[j].w * v[j].w); }
    const float rstd = 1.0f / sqrtf(wave_sum(s) * (1.f / D) + 1e-6f);
    GAS unsigned long long* o8 = (GAS unsigned long long*)orow + F.lane;
#pragma unroll
    for (int j = 0; j < 4; ++j) {
        const f32x4 g = ((const GAS f32x4*)nw)[F.lane + 64 * j], a = ((const GAS f32x4*)sc)[F.lane + 64 * j], b = ((const GAS f32x4*)sh)[F.lane + 64 * j];
        const f32x4 h = (v[j] * rstd * g) * (a + 1.0f) + b;
        o8[64 * j] = (unsigned long long)pk2(h.x, h.y) | ((unsigned long long)pk2(h.z, h.w) << 32);
    }
}
__device__ __forceinline__ void norm_mod_pass(Frame& F, const Ptrs& P, const float* src, const float* nw, int sc_off, int sh_off) {
    const int gw = F.vcu * NWAVES + F.wave, NGW = F.G * NWAVES, per = M / NGW;
    for (int i = 0; i < per; ++i) { const int m = gw * per + i; const int b = m / SEQ;
        mod_row(F, src + (size_t)m * D, P.XN + (size_t)m * D, nw, P.mod + b * NMOD + sc_off, P.mod + b * NMOD + sh_off); }
}
__device__ __forceinline__ void final_norm_pass(Frame& F, const Ptrs& P) {
    const int gw = F.vcu * NWAVES + F.wave, NGW = F.G * NWAVES, per = M / NGW;
    for (int i = 0; i < per; ++i) { const int m = gw * per + i;
        GAS f32x4* xr = (GAS f32x4*)(P.out + (size_t)m * D) + F.lane;
        f32x4 v[4]; float s = 0.f;
#pragma unroll
        for (int j = 0; j < 4; ++j) { v[j] = xr[64 * j]; s += (v[j].x * v[j].x + v[j].y * v[j].y) + (v[j].z * v[j].z + v[j].w * v[j].w); }
        const float rstd = 1.0f / sqrtf(wave_sum(s) * (1.f / D) + 1e-6f);
#pragma unroll
        for (int j = 0; j < 4; ++j) { const f32x4 g = ((const GAS f32x4*)P.norm_f)[F.lane + 64 * j]; xr[64 * j] = v[j] * rstd * g; }
    }
}
__device__ __forceinline__ void ik_pass(Frame& F, const Ptrs& P) {
    const int gw = F.vcu * NWAVES + F.wave, NGW = F.G * NWAVES, per = M / NGW;
    const float lw = P.lnw[F.lane], lb = P.lnb[F.lane];
    for (int i = 0; i < per; ++i) { const int m = gw * per + i;
        const float v = P.raw[(size_t)m * 80 + F.lane];
        const float mu = wave_sum(v) * (1.f / 64.f); const float dv = v - mu;
        const float var = wave_sum(dv * dv) * (1.f / 64.f);
        const float y = dv * (1.0f / sqrtf(var + 1e-5f)) * lw + lb;
        const float other = __shfl_xor(y, 32);
        const int j = F.lane & 31; const float cs = P.cosT[(size_t)m * 32 + j], sn = P.sinT[(size_t)m * 32 + j];
        const float o = F.lane < 32 ? y * cs - other * sn : y * cs + other * sn;
        P.IK[(size_t)m * 64 + perm64(F.lane)] = (bf16)f2bf(o);
        if (F.lane < 8) P.iw[(size_t)m * 8 + F.lane] = P.raw[(size_t)m * 80 + 64 + F.lane] * (0.35355339059327373f * 0.125f);
    }
}
__device__ __forceinline__ void diff_combine_pass(Frame& F, const Ptrs& P) {
    const int gw = F.vcu * NWAVES + F.wave, NGW = F.G * NWAVES, per = M / NGW;
    const float s1 = wave_sum(P.lq1[F.lane] * P.lk1[F.lane]), s2 = wave_sum(P.lq2[F.lane] * P.lk2[F.lane]);
    const float lam = __expf(s1) - __expf(s2) + 0.2f;
    const float g0 = P.subln[2 * F.lane] * 0.8f, g1 = P.subln[2 * F.lane + 1] * 0.8f;
    for (int i = 0; i < per; ++i) { const int m = gw * per + i;
        const GAS unsigned* od = (const GAS unsigned*)(P.ODIFF + (size_t)m * D);
        GAS unsigned* mx = (GAS unsigned*)(P.MIX + (size_t)m * D + 512);
#pragma unroll
        for (int h = 0; h < 4; ++h) {
            const unsigned a = od[(h * 2 + 0) * 64 + F.lane], b = od[(h * 2 + 1) * 64 + F.lane];
            const float v0 = __uint_as_float(a << 16) - lam * __uint_as_float(b << 16), v1 = __uint_as_float(a & 0xFFFF0000u) - lam * __uint_as_float(b & 0xFFFF0000u);
            const float r = 1.0f / sqrtf(wave_sum(v0 * v0 + v1 * v1) * (1.f / 128.f) + 1e-6f);
            mx[h * 64 + F.lane] = pk2(v0 * r * g0, v1 * r * g1);
        }
    }
}

constexpr int SEL_ROWB = 8200;
typedef unsigned short u16x2 __attribute__((ext_vector_type(2)));
__device__ __forceinline__ unsigned cnt_lt2(unsigned code, unsigned candpair) {
    const u16x2 c = __builtin_bit_cast(u16x2, code), t = __builtin_bit_cast(u16x2, candpair);
    u16x2 d = __builtin_elementwise_sub_sat(t, c); const u16x2 one = {1, 1};
    d = __builtin_elementwise_min(d, one);
    return __builtin_bit_cast(unsigned, d);
}
__device__ __forceinline__ unsigned sortable2(unsigned bits) { return bits ^ (((bits & 0x80008000u) >> 15) * 0x7FFFu + 0x80008000u); }
#define OPAQUE_S(x) asm volatile("" : "+s"(x))
__device__ __forceinline__ int count_lt(const unsigned (&c)[32], int NP, unsigned t) {
    OPAQUE_S(NP);
    const unsigned cp = t | (t << 16); unsigned a = 0u;
#pragma unroll
    for (int p = 0; p < 32; ++p) if (p < NP) a += cnt_lt2(c[p], cp);
    const int l = (int)((a & 0xFFFFu) + (a >> 16));
    return __builtin_amdgcn_readfirstlane(wave_sum_i(l));
}
__device__ __forceinline__ int tie_kappa(const unsigned (&code)[32], int NP, unsigned T, int need) {
    int running = 0, kappa = 4095; bool found = false; OPAQUE_S(NP);
#pragma unroll
    for (int p = 0; p < 32; ++p) if (p < NP) {
#pragma unroll
        for (int hf = 0; hf < 2; ++hf) {
            const unsigned v = hf ? (code[p] >> 16) : (code[p] & 0xFFFFu);
            unsigned long long mm = __ballot(v == T);
            if (!found) { const int c = __popcll(mm);
                if (running + c >= need) { int n = need - running; while (--n > 0) mm &= mm - 1ull; kappa = 128 * p + 64 * hf + (__ffsll((long long)mm) - 1); found = true; }
                else running += c; }
            __builtin_amdgcn_sched_barrier(0);
        } }
    return kappa;
}
__device__ __forceinline__ unsigned long long sel_words(const unsigned (&code)[32], int NP, unsigned T, int kappa, int t, int lane) {
    unsigned long long mine = 0ull; OPAQUE_S(NP);
#pragma unroll
    for (int p = 0; p < 32; ++p) if (p < NP) {
#pragma unroll
        for (int hf = 0; hf < 2; ++hf) {
            const unsigned v = hf ? (code[p] >> 16) : (code[p] & 0xFFFFu); const int key = 128 * p + 64 * hf + lane;
            const bool sel = (key <= t) && ((v > T) || (v == T && key <= kappa));
            const unsigned long long mm = __ballot(sel);
            if (lane == 2 * p + hf) mine = mm;
            __builtin_amdgcn_sched_barrier(0);
        } }
    return mine;
}
__device__ __forceinline__ void sel_unit(Frame& F, const Ptrs& P, int b, int qb) {
    const int q0 = qb * 16, lane = F.lane, wave = F.wave; const size_t rowb = (size_t)b * SEQ;
    unsigned long long* Wout = P.WM + (rowb + q0) * 64;
    if (q0 < 256) {
#pragma unroll
        for (int qq = 0; qq < 2; ++qq) { const int t = q0 + 2 * wave + qq, dt = t >> 6, rem = t & 63;
            const unsigned long long full = ~0ull, part = rem == 63 ? full : ((1ull << (rem + 1)) - 1ull);
            Wout[(2 * wave + qq) * 64 + lane] = lane < dt ? full : (lane == dt ? part : 0ull); }
        return;
    }
    LAS unsigned char* S = F.lds + RING_OFF;
    {
        const int qn = lane & 15, kq = lane >> 4;
        const bf16* iqp = P.QKV + (size_t)3 * M * 512 + (rowb + q0 + qn) * 512 + kq * 8;
        bf16x8 qf[8][2]; float wq[8];
#pragma unroll
        for (int h = 0; h < 8; ++h) { qf[h][0] = *(const bf16x8*)(iqp + h * 64); qf[h][1] = *(const bf16x8*)(iqp + h * 64 + 32); wq[h] = P.iw[(rowb + q0 + qn) * 8 + h]; }
        const int NS = qb + 1;
        for (int s = wave; s < NS; s += NWAVES) {
            const bf16* ikp = P.IK + (rowb + 16 * s + qn) * 64 + kq * 8;
            const bf16x8 k0 = *(const bf16x8*)ikp, k1 = *(const bf16x8*)(ikp + 32);
            f32x4 I = {0.f, 0.f, 0.f, 0.f};
#pragma unroll
            for (int h = 0; h < 8; ++h) {
                f32x4 x = __builtin_amdgcn_mfma_f32_16x16x32_bf16(k0, qf[h][0], (f32x4){0.f, 0.f, 0.f, 0.f}, 0, 0, 0);
                x = __builtin_amdgcn_mfma_f32_16x16x32_bf16(k1, qf[h][1], x, 0, 0, 0);
#pragma unroll
                for (int i = 0; i < 4; ++i) I[i] += wq[h] * __builtin_fmaxf(x[i], 0.f);
            }
            unsigned h16[4];
#pragma unroll
            for (int i = 0; i < 4; ++i) { const _Float16 hv = (_Float16)I[i]; h16[i] = (unsigned)__builtin_bit_cast(unsigned short, hv); }
            if (s == NS - 1) {
#pragma unroll
                for (int i = 0; i < 4; ++i) if (4 * kq + i > qn) h16[i] = 0xFC00u;
            }
            const unsigned long long pk = (unsigned long long)(h16[0] | (h16[1] << 16)) | ((unsigned long long)(h16[2] | (h16[3] << 16)) << 32);
            *(LAS unsigned long long*)(S + qn * SEL_ROWB + 2 * (16 * s + 4 * kq)) = pk;
        }
    }
    __syncthreads();
    const int nk = q0 + 16, NP0 = __builtin_amdgcn_readfirstlane((nk + 127) >> 7), TOT = NP0 * 128;
#pragma unroll 1
    for (int qq = 0; qq < 2; ++qq) {
        const int ql = 2 * wave + qq, t = q0 + ql;
        int ln = lane; asm volatile("" : "+v"(ln));
        unsigned c[32]; int NP = NP0; OPAQUE_S(NP);
        const LAS unsigned char* r0 = S + ql * SEL_ROWB;
#pragma unroll
        for (int p = 0; p < 32; ++p) {
            c[p] = 0x03FF03FFu;
            if (p < NP) {
                const int klo = 128 * p + ln, khi = klo + 64;
                unsigned a0 = 0xFC00u, b0 = 0xFC00u;
                if (klo < nk) a0 = *(const LAS unsigned short*)(r0 + 2 * klo);
                if (khi < nk) b0 = *(const LAS unsigned short*)(r0 + 2 * khi);
                c[p] = sortable2(a0 | (b0 << 16));
            }
        }
        unsigned T = 0u;
#pragma unroll 1
        for (int bit = 15; bit >= 0; --bit) { const unsigned n = T | (1u << bit); if (TOT - count_lt(c, NP, n) >= 256) T = n; }
        const int ge = TOT - count_lt(c, NP, T), gt = TOT - count_lt(c, NP, T + 1u);
        const int need = 256 - gt;
        int kap = 4095;
        if (ge - gt > need) kap = tie_kappa(c, NP, T, need);
        Wout[ql * 64 + lane] = sel_words(c, NP, T, kap, t, ln);
    }
    __syncthreads();
}

struct Args { const void* in[19]; float* out; unsigned char* ws; int ph_lo, ph_hi; };
constexpr int N_PHASES = 11;
__device__ __forceinline__ void fill_ptrs(Ptrs& P, const Args* ka) {
    unsigned char* ws = ka->ws;
    P.x = (const float*)ka->in[0]; P.c = (const float*)ka->in[1]; P.pos = (const int*)ka->in[2]; P.w_ada = (const float*)ka->in[3]; P.b_ada = (const float*)ka->in[4];
    P.norm1_w = (const float*)ka->in[5]; P.w_in = (const float*)ka->in[6]; P.lnw = (const float*)ka->in[7]; P.lnb = (const float*)ka->in[8];
    P.lq1 = (const float*)ka->in[9]; P.lk1 = (const float*)ka->in[10]; P.lq2 = (const float*)ka->in[11]; P.lk2 = (const float*)ka->in[12];
    P.subln = (const float*)ka->in[13]; P.w_out = (const float*)ka->in[14]; P.norm2_w = (const float*)ka->in[15]; P.w_ff1 = (const float*)ka->in[16];
    P.w_ff2 = (const float*)ka->in[17]; P.norm_f = (const float*)ka->in[18]; P.out = ka->out;
    P.mod = (float*)(ws + WS_MOD); P.cosT = (float*)(ws + WS_COS); P.sinT = (float*)(ws + WS_SIN); P.raw = (float*)(ws + WS_RAW); P.iw = (float*)(ws + WS_IW);
    P.Win = (bf16*)(ws + WS_WIN); P.Wout = (bf16*)(ws + WS_WOUT); P.W1 = (bf16*)(ws + WS_W1); P.W2 = (bf16*)(ws + WS_W2);
    P.QKV = (bf16*)(ws + WS_QKV); P.ODIFF = (bf16*)(ws + WS_ODIFF); P.MIX = (bf16*)(ws + WS_MIX); P.XN = (bf16*)(ws + WS_XN); P.IK = (bf16*)(ws + WS_IK); P.H = (bf16*)(ws + WS_H);
    P.WM = (unsigned long long*)(ws + WS_WM);
}
__global__ void __launch_bounds__(NWAVES * 64, 2) mega_fwd(Args args) {
    extern __shared__ __attribute__((aligned(16))) unsigned char lds[];
    Frame F;
    F.lds = (LAS unsigned char*)lds;
    F.MISC = (volatile LAS unsigned*)(F.lds + MISC_OFF);
    F.tid = threadIdx.x; F.lane = F.tid & 63; F.wave = __builtin_amdgcn_readfirstlane(F.tid >> 6);
    F.G = GRID; { const int bx = blockIdx.x; F.vcu = (bx % 8) * (GRID / 8) + bx / 8; }
#define BX_FROM_VCU ((F.vcu % (GRID / 8)) * 8 + F.vcu / (GRID / 8))
    F.ctl = (gu32*)(args.ws + WS_CTL);
#define PHASE_BEGIN() \
    Ptrs P; { const Args* ka = (const Args*)__builtin_amdgcn_kernarg_segment_ptr(); asm volatile("" : "+s"(ka)); fill_ptrs(P, ka); } \
    { int l_ = (int)__builtin_amdgcn_mbcnt_hi(~0u, __builtin_amdgcn_mbcnt_lo(~0u, 0u)); asm volatile("" : "+v"(l_)); F.lane = l_; F.tid = F.wave * 64 + l_; asm volatile("" : "+s"(F.vcu)); }
    for (int u = F.tid; u < (LDS_BYTES - LDSCTL_OFF) / 4; u += NWAVES * 64) ((LAS unsigned*)(F.lds + LDSCTL_OFF))[u] = 0u;
    __syncthreads();
    const int lo = args.ph_lo, hi = args.ph_hi;
    const bool single = (hi - lo) > 1;
    XcdBarrier bar; bar.bar = (unsigned*)(F.ctl + CW_BAR); bar.x = 0; bar.st = nullptr;
    if (single) bar = xcd_barrier_post((unsigned*)(F.ctl + CW_BAR), F.MISC + 8, F.tid);
#ifndef PH_EN
#define PH_EN 0x7FF
#endif
#define IN(k) (((PH_EN >> (k)) & 1) && lo <= (k) && (k) < hi)
#define SEAM(k) do { if (IN(k) && IN((k) + 1)) { int l_ = (int)__builtin_amdgcn_mbcnt_hi(~0u, __builtin_amdgcn_mbcnt_lo(~0u, 0u)); xcd_barrier(bar, F.wave * 64 + l_); } } while (0)
    typedef attn_body::bf16 abf;

    if (IN(0)) { PHASE_BEGIN(); p0a(F, P); } SEAM(0);
    if (IN(1)) { PHASE_BEGIN(); norm_mod_pass(F, P, P.x, P.norm1_w, 1 * D, 0 * D); } SEAM(1);
    if (IN(2)) { PHASE_BEGIN();
        pg8::Gemm g{P.XN, P.Win, M, NIN, D}; pg8::StaticOrder S; S.init(M, NIN, GRID, BX_FROM_VCU);
        pg8::EpiInProj E{P.QKV, P.raw, P.cosT, P.sinT, C2, M};
        pg8::gemm_phase<pg8::EpiInProj, pg8::StaticOrder, PG8_ALIGN, PG8_SP2>(F.lds + RING_OFF, g, S, E, F.tid);
    } SEAM(2);
    if (IN(3)) { PHASE_BEGIN();
        ik_pass(F, P);
        const attn_body::AttnTensors AT{(const abf*)P.QKV + (size_t)4 * M * 512, (const abf*)P.QKV + (size_t)5 * M * 512, (const abf*)P.QKV + (size_t)6 * M * 512, (abf*)P.ODIFF, nullptr};
        const attn_body::DiffOrder S(F.vcu);
        attn_body::attn_phase<attn_body::DiffOrder, false, 512, 512, 1024, SEQ>((char*)lds + RING_OFF, AT, S, F.tid);
    } SEAM(3);
    if (IN(4)) { PHASE_BEGIN();
        diff_combine_pass(F, P);
        const int b = F.vcu >> 6, j = F.vcu & 63;
        for (int i = 0; i < 4; ++i) { const int qb = (i == 0) ? j : (i == 1) ? 127 - j : (i == 2) ? 128 + j : 255 - j; sel_unit(F, P, b, qb); }
    } SEAM(4);
    if (IN(5)) { PHASE_BEGIN();
        const attn_body::AttnTensors AT{(const abf*)P.QKV, (const abf*)P.QKV + (size_t)1 * M * 512, (const abf*)P.QKV + (size_t)2 * M * 512, (abf*)P.MIX, P.WM};
        const attn_body::DsaOrder S(F.vcu);
        attn_body::attn_phase<attn_body::DsaOrder, true, 512, 512, 1024, SEQ>((char*)lds + RING_OFF, AT, S, F.tid);
    } SEAM(5);
    if (IN(6)) { PHASE_BEGIN();
        pg8::Gemm g{P.MIX, P.Wout, M, D, D}; pg8::StaticOrder S; S.init(M, D, GRID, BX_FROM_VCU);
        pg8::EpiResGate E{P.x, P.out, P.mod + 2 * D, D, SEQ, NMOD};
        pg8::gemm_phase<pg8::EpiResGate, pg8::StaticOrder, PG8_ALIGN, PG8_SP2>(F.lds + RING_OFF, g, S, E, F.tid);
    } SEAM(6);
    if (IN(7)) { PHASE_BEGIN(); norm_mod_pass(F, P, P.out, P.norm2_w, 4 * D, 3 * D); } SEAM(7);
    if (IN(8)) { PHASE_BEGIN();
        pg8::Gemm g{P.XN, P.W1, M, FF, D}; pg8::StaticOrder S; S.init(M, FF, GRID, BX_FROM_VCU);
        pg8::EpiBf16<2> E{P.H, FF};
        pg8::gemm_phase<pg8::EpiBf16<2>, pg8::StaticOrder, PG8_ALIGN, PG8_SP2>(F.lds + RING_OFF, g, S, E, F.tid);
    } SEAM(8);
    if (IN(9)) { PHASE_BEGIN();
        pg8::Gemm g{P.H, P.W2, M, D, FF}; pg8::StaticOrder S; S.init(M, D, GRID, BX_FROM_VCU);
        pg8::EpiResGate E{P.out, P.out, P.mod + 5 * D, D, SEQ, NMOD};
        pg8::gemm_phase<pg8::EpiResGate, pg8::StaticOrder, PG8_ALIGN, PG8_SP2>(F.lds + RING_OFF, g, S, E, F.tid);
    } SEAM(9);
    if (IN(10)) { PHASE_BEGIN(); final_norm_pass(F, P); }
#undef IN
#undef SEAM
}

#ifndef MK_PER_PHASE
#define MK_PER_PHASE 0
#endif
extern "C" void kernel_launch(void* const* d_in, const int* in_sizes, int n_in, void* d_out, int out_size, void* d_ws, size_t ws_size, hipStream_t stream) {
    static int grid = 0;
    if (grid == 0) {
        if (n_in != 19 || in_sizes[0] != M * D || out_size != M * D || ws_size < WS_END) { fprintf(stderr, "kernel_launch: unexpected shapes (n_in %d, in0 %d, out %d, ws %zu); nothing launched\n", n_in, n_in > 0 ? in_sizes[0] : -1, out_size, ws_size); grid = -1; return; }
        int dev = 0, cus = 0, per_cu = 0;
        if (hipGetDevice(&dev) != hipSuccess || hipDeviceGetAttribute(&cus, hipDeviceAttributeMultiprocessorCount, dev) != hipSuccess) { grid = -1; return; }
        if (hipFuncSetAttribute((const void*)mega_fwd, hipFuncAttributeMaxDynamicSharedMemorySize, LDS_BYTES) != hipSuccess) { fprintf(stderr, "kernel_launch: hipFuncSetAttribute failed\n"); grid = -1; return; }
        if (hipOccupancyMaxActiveBlocksPerMultiprocessor(&per_cu, (const void*)mega_fwd, NWAVES * 64, LDS_BYTES) != hipSuccess || per_cu < 1)
            fprintf(stderr, "kernel_launch: note: occupancy query reports %d workgroups per CU\n", per_cu);
        (void)hipGetLastError();
        grid = GRID;
        if (cus != 256) fprintf(stderr, "kernel_launch: device reports %d CUs; this kernel is scheduled for 256\n", cus);
    }
    if (grid < 0) return;
    if (hipMemsetAsync((char*)d_ws + WS_CTL, 0, CTL_ZERO_BYTES, stream) != hipSuccess) { fprintf(stderr, "kernel_launch: hipMemsetAsync failed\n"); return; }
    Args a; memset(&a, 0, sizeof(a));
    for (int i = 0; i < 19; ++i) a.in[i] = d_in[i];
    a.out = (float*)d_out; a.ws = (unsigned char*)d_ws;
#if MK_PER_PHASE
    for (int ph = 0; ph < N_PHASES; ++ph) { a.ph_lo = ph; a.ph_hi = ph + 1; hipLaunchKernelGGL(mega_fwd, dim3(grid), dim3(NWAVES * 64), LDS_BYTES, stream, a); }
#else
    a.ph_lo = 0; a.ph_hi = N_PHASES;
    hipLaunchKernelGGL(mega_fwd, dim3(grid), dim3(NWAVES * 64), LDS_BYTES, stream, a);
#endif
    const hipError_t le = hipPeekAtLastError();
    if (le != hipSuccess) fprintf(stderr, "kernel_launch: launch failed: %s\n", hipGetErrorName(le));
}
```

```cpp
#include <hip/hip_runtime.h>
#include <cstdio>
#include <cstdint>
#include <cstring>
namespace pg8 {
#define PG8_LAS __attribute__((address_space(3)))
typedef unsigned short bf16_t;
typedef short bf16x8 __attribute__((ext_vector_type(8)));
typedef float f32x4 __attribute__((ext_vector_type(4)));
typedef unsigned u32x4 __attribute__((ext_vector_type(4)));
constexpr int BM = 256, BK = 64, HALF = 128, HTB = HALF * BK * 2  , STAGE_BYTES = 8 * HTB, NXCD = 8, WGM = 8;

__host__ __device__ __forceinline__ int lds_byte(int r, int c) { const int st = (r >> 4) * 2 + (c >> 5), rr = r & 15, cc = c & 31, ob = rr * 64 + cc * 2; return st * 1024 + (ob ^ (((ob >> 9) & 1) << 5)); }
__host__ __device__ __forceinline__ void stage_rc(int b, int& R, int& C) { const int st = b / 1024, sb = b % 1024, swz = sb ^ (((sb >> 9) & 1) << 5); R = (st >> 1) * 16 + swz / 64; C = (st & 1) * 32 + (swz % 64) / 2; }
__host__ __device__ __forceinline__ int perm32(int rho) { const int n = rho >> 4, i = rho & 15; return 8 * (i >> 2) + 4 * n + (i & 3); }

struct Unit { int pm, pn; };
struct Gemm { const bf16_t* A; const bf16_t* Bt; int M, N, K; };

struct StaticOrder {
    int nM, nN, nwg, G, c;
    __host__ __device__ void init(int M, int N, int G_, int c_) { nM = M / BM; nN = N / BM; nwg = nM * nN; G = G_; c = c_; }
    __host__ __device__ bool next(int i, Unit& u) const {
        const long L = (long)i * G + c; if (L >= nwg) return false;
        int wgid = (int)L; { const int q = nwg / NXCD, r = nwg % NXCD, xcd = wgid % NXCD, off = wgid / NXCD; wgid = (xcd < r ? xcd * (q + 1) : r * (q + 1) + (xcd - r) * q) + off; }
        const int nig = WGM * nN, gid = wgid / nig, fm = gid * WGM, gsz = (nM - fm) < WGM ? (nM - fm) : WGM;
        u.pm = fm + ((wgid % nig) % gsz); u.pn = (wgid % nig) / gsz; return true;
    }
    __device__ __forceinline__ void a_ready(const Unit&) const {}
    __device__ __forceinline__ void done(const Unit&) const {}
};

__device__ __forceinline__ unsigned cvt_pk_bf16(float lo, float hi) { unsigned r; asm volatile("v_cvt_pk_bf16_f32 %0, %1, %2" : "=v"(r) : "v"(lo), "v"(hi)); return r; }

template <int ACT  > struct EpiBf16 {
    static constexpr bool PERM = true, AFTER_DRAIN = false;
    bf16_t* O; int ldc;
    __device__ __forceinline__ void operator()(const f32x4 (&acc)[2][2][4][2], const Unit& u, int wr, int wc, int fr, int fq) const {
        const int row0 = u.pm * BM + wr * 64 + fr; const int col0 = u.pn * BM + wc * 32 + 8 * fq;
#pragma unroll
        for (int ai = 0; ai < 2; ++ai)
#pragma unroll
            for (int m = 0; m < 4; ++m) { bf16_t* rowp = O + (size_t)(row0 + ai * HALF + m * 16) * ldc + col0;
#pragma unroll
                for (int bj = 0; bj < 2; ++bj) { f32x4 v0 = acc[ai][bj][m][0], v1 = acc[ai][bj][m][1];
                    if (ACT == 2) {
#pragma unroll
                        for (int e = 0; e < 4; ++e) { const float a = __builtin_fmaxf(v0[e], 0.f), b = __builtin_fmaxf(v1[e], 0.f); v0[e] = a * a; v1[e] = b * b; } }
                    u32x4 w; w.x = cvt_pk_bf16(v0[0], v0[1]); w.y = cvt_pk_bf16(v0[2], v0[3]); w.z = cvt_pk_bf16(v1[0], v1[1]); w.w = cvt_pk_bf16(v1[2], v1[3]);
                    *(u32x4*)(rowp + bj * HALF) = w; } }
    }
};

struct EpiResGate {
    static constexpr bool PERM = true, AFTER_DRAIN = false;
    const float* resid; float* out; const float* gate; int ldc; int rows_per_batch; int gate_stride;
    __device__ __forceinline__ void operator()(const f32x4 (&acc)[2][2][4][2], const Unit& u, int wr, int wc, int fr, int fq) const {
        const int row0 = u.pm * BM + wr * 64 + fr; const int col0 = u.pn * BM + wc * 32 + 8 * fq;
        const float* g = gate + (size_t)((u.pm * BM) / rows_per_batch) * gate_stride + col0;
        f32x4 gv[2][2];
#pragma unroll
        for (int bj = 0; bj < 2; ++bj) { gv[bj][0] = *(const f32x4*)(g + bj * HALF); gv[bj][1] = *(const f32x4*)(g + bj * HALF + 4); }
#pragma unroll
        for (int ai = 0; ai < 2; ++ai)
#pragma unroll
            for (int m = 0; m < 4; ++m) { const size_t off = (size_t)(row0 + ai * HALF + m * 16) * ldc + col0;
#pragma unroll
                for (int bj = 0; bj < 2; ++bj) {
                    const f32x4 r0 = *(const f32x4*)(resid + off + bj * HALF), r1 = *(const f32x4*)(resid + off + bj * HALF + 4);
                    *(f32x4*)(out + off + bj * HALF) = r0 + gv[bj][0] * acc[ai][bj][m][0];
                    *(f32x4*)(out + off + bj * HALF + 4) = r1 + gv[bj][1] * acc[ai][bj][m][1]; } }
    }
};

struct EpiInProj {
    static constexpr bool PERM = true, AFTER_DRAIN = false;
    bf16_t* qkv;
    float* raw;
    const float* cosT; const float* sinT;
    float c2; int Mrows;
    __device__ __forceinline__ void operator()(const f32x4 (&acc)[2][2][4][2], const Unit& u, int wr, int wc, int fr, int fq) const {
        const int pn = u.pn; const int row0 = u.pm * BM + wr * 64 + fr;
        if (pn == 8) {
            const int c = wc * 32 + 8 * fq;
            if (c < 72) {
#pragma unroll
                for (int ai = 0; ai < 2; ++ai)
#pragma unroll
                    for (int m = 0; m < 4; ++m) { float* rp = raw + (size_t)(row0 + ai * HALF + m * 16) * 80 + c;
                        *(f32x4*)rp = acc[ai][0][m][0]; *(f32x4*)(rp + 4) = acc[ai][0][m][1]; } }
            return;
        }
        const int t = pn < 8 ? pn : pn - 9; const int bi = (pn < 8 ? 0 : 4) + (t >> 1); const int colbase = (t & 1) * 256;
        bf16_t* base = qkv + (size_t)bi * Mrows * 512;
        const bool rope = !(bi == 2 || bi == 6); const float sc = (bi == 0 || bi == 4) ? c2 : 1.f;
        const int col0 = colbase + wc * 32 + 8 * fq; const int j0 = 16 * (wc & 1) + 4 * fq;
#pragma unroll
        for (int ai = 0; ai < 2; ++ai)
#pragma unroll
            for (int m = 0; m < 4; ++m) { const int row = row0 + ai * HALF + m * 16; bf16_t* rowp = base + (size_t)row * 512 + col0;
                f32x4 cs = {sc, sc, sc, sc}, sn = {0.f, 0.f, 0.f, 0.f};
                if (rope) { cs = *(const f32x4*)(cosT + (size_t)row * 32 + j0) * sc; sn = *(const f32x4*)(sinT + (size_t)row * 32 + j0) * sc; }
#pragma unroll
                for (int bj = 0; bj < 2; ++bj) { const f32x4 x1 = acc[ai][bj][m][0], x2 = acc[ai][bj][m][1];
                    const f32x4 o1 = x1 * cs - x2 * sn, o2 = x2 * cs + x1 * sn;
                    u32x4 w; w.x = cvt_pk_bf16(o1[0], o1[1]); w.y = cvt_pk_bf16(o1[2], o1[3]); w.z = cvt_pk_bf16(o2[0], o2[1]); w.w = cvt_pk_bf16(o2[2], o2[3]);
                    *(u32x4*)(rowp + bj * HALF) = w; } }
    }
};

template <class Epi, class Sched, bool ALIGN_EPI = false, bool SP2 = false>
__device__ __forceinline__ void gemm_phase(PG8_LAS unsigned char* lds, const Gemm g, const Sched& S, const Epi& E, const int tid  ) {
    const int wid = __builtin_amdgcn_readfirstlane(tid >> 6), lane = tid & 63, wr = wid >> 2, wc = wid & 3, fr = lane & 15, fq = lane >> 4;
    const int K = g.K, nt = K / BK;
    unsigned voffA[2], voffB[2];
#pragma unroll
    for (int i = 0; i < 2; ++i) { int R, C; stage_rc(tid * 16 + i * 8192, R, C); const int Rb = Epi::PERM ? ((R & ~31) + perm32(R & 31)) : R;
        voffA[i] = (unsigned)(R * K + C) * 2u; voffB[i] = (unsigned)(Rb * K + C) * 2u; }
    const size_t kstep = (size_t)(BK * 2);
    const size_t hstep = (size_t)HALF * K * 2;
    const size_t tstep = 2 * hstep;
    const unsigned ldsw = (unsigned)wid * 1024u;
    const int aoff = lds_byte(wr * 64 + fr, fq * 8), boff = lds_byte(wc * 32 + fr, fq * 8);
#define PG8_SA(b, h) (((b) * 2 + (h)) * HTB)
#define PG8_SB(b, h) ((4 + (b) * 2 + (h)) * HTB)
#define PG8_STAGE(bufoff, gbase, voff) do { _Pragma("unroll") for (int _i = 0; _i < 2; ++_i) \
        __builtin_amdgcn_global_load_lds((const unsigned*)((const char*)(gbase) + (voff)[_i]), (PG8_LAS unsigned*)(lds + (bufoff) + ldsw + _i * 8192), 16, 0, 0); } while (0)
#define PG8_LDA(dst, b, h) do { _Pragma("unroll") for (int m = 0; m < 4; ++m) _Pragma("unroll") for (int k = 0; k < 2; ++k) dst[m][k] = *(const PG8_LAS bf16x8*)(lds + PG8_SA(b, h) + aoff + m * 2048 + k * 1024); } while (0)
#define PG8_LDB(dst, b, h) do { _Pragma("unroll") for (int n = 0; n < 2; ++n) _Pragma("unroll") for (int k = 0; k < 2; ++k) dst[n][k] = *(const PG8_LAS bf16x8*)(lds + PG8_SB(b, h) + boff + n * 2048 + k * 1024); } while (0)
#define PG8_MMA(ai, bj, At, Bt) do { __builtin_amdgcn_s_setprio(1); _Pragma("unroll") for (int m = 0; m < 4; ++m) _Pragma("unroll") for (int n = 0; n < 2; ++n) _Pragma("unroll") for (int k = 0; k < 2; ++k) \
        acc[ai][bj][m][n] = __builtin_amdgcn_mfma_f32_16x16x32_bf16(Bt[n][k], At[m][k], acc[ai][bj][m][n], 0, 0, 0); __builtin_amdgcn_s_setprio(0); } while (0)
#define PG8_WAIT_V(n) asm volatile("s_waitcnt vmcnt(" #n ")" ::: "memory")
#define PG8_WAIT_L(n) asm volatile("s_waitcnt lgkmcnt(" #n ")" ::: "memory")
#define PG8_BAR __builtin_amdgcn_s_barrier()
#define PG8_SCHED __builtin_amdgcn_sched_barrier(0)
    Unit cur, nxt; int ui = 0;
    if (!S.next(0, cur)) return;
    f32x4 acc[2][2][4][2];
#pragma unroll
    for (int a = 0; a < 2; ++a)
#pragma unroll
        for (int b = 0; b < 2; ++b)
#pragma unroll
            for (int m = 0; m < 4; ++m)
#pragma unroll
                for (int n = 0; n < 2; ++n) acc[a][b][m][n] = (f32x4){0.f, 0.f, 0.f, 0.f};
    bf16x8 At[4][2], B0[2][2], B1[2][2];
    const char* cA = (const char*)g.A + (size_t)cur.pm * tstep; const char* cB = (const char*)g.Bt + (size_t)cur.pn * tstep;
    S.a_ready(cur);
    if constexpr (SP2) {
        PG8_STAGE(PG8_SB(0, 0), cB, voffB); PG8_STAGE(PG8_SB(0, 1), cB + hstep, voffB); PG8_STAGE(PG8_SA(0, 0), cA, voffA); PG8_STAGE(PG8_SA(0, 1), cA + hstep, voffA);
        if (wr == 1) PG8_BAR;
        PG8_WAIT_V(2); PG8_BAR;
        PG8_STAGE(PG8_SB(1, 0), cB + kstep, voffB); PG8_STAGE(PG8_SA(1, 0), cA + kstep, voffA); PG8_STAGE(PG8_SB(1, 1), cB + hstep + kstep, voffB);
        PG8_WAIT_V(6); PG8_BAR;
    } else {
        PG8_STAGE(PG8_SB(0, 0), cB, voffB); PG8_STAGE(PG8_SA(0, 0), cA, voffA); PG8_STAGE(PG8_SB(0, 1), cB + hstep, voffB); PG8_STAGE(PG8_SA(0, 1), cA + hstep, voffA);
        if (wr == 1) PG8_BAR;
        PG8_WAIT_V(4); PG8_BAR;
        PG8_STAGE(PG8_SB(1, 0), cB + kstep, voffB); PG8_STAGE(PG8_SA(1, 0), cA + kstep, voffA); PG8_STAGE(PG8_SB(1, 1), cB + hstep + kstep, voffB);
        PG8_WAIT_V(6); PG8_BAR;
    }
    for (;;) {
        const bool has_next = S.next(ui + 1, nxt);
        const char* nA = has_next ? (const char*)g.A + (size_t)nxt.pm * tstep : cA; const char* nB = has_next ? (const char*)g.Bt + (size_t)nxt.pn * tstep : cB;
        for (int t = 0; t < nt; t += 2) {
            const bool last = (t == nt - 2);
            const char* a1 = cA + (size_t)(t + 1) * kstep;
            const char* a2 = last ? nA : cA + (size_t)(t + 2) * kstep; const char* b2 = last ? nB : cB + (size_t)(t + 2) * kstep;
            const char* a3 = a2 + kstep; const char* b3 = b2 + kstep;
            if (last && has_next) S.a_ready(nxt);
            if constexpr (SP2) {
            PG8_LDB(B0, 0, 0); PG8_LDB(B1, 0, 1); PG8_SCHED; PG8_LDA(At, 0, 0); PG8_STAGE(PG8_SA(1, 1), a1 + hstep, voffA);
            PG8_WAIT_V(8); PG8_WAIT_L(0); PG8_BAR; PG8_MMA(0, 0, At, B0); PG8_MMA(0, 1, At, B1); PG8_BAR; PG8_SCHED;
            PG8_LDA(At, 0, 1); PG8_STAGE(PG8_SB(0, 0), b2, voffB); PG8_STAGE(PG8_SB(0, 1), b2 + hstep, voffB); PG8_STAGE(PG8_SA(0, 0), a2, voffA);
            PG8_WAIT_V(8); PG8_WAIT_L(0); PG8_BAR; PG8_MMA(1, 0, At, B0); PG8_MMA(1, 1, At, B1); PG8_BAR; PG8_SCHED;
            PG8_LDB(B0, 1, 0); PG8_LDB(B1, 1, 1); PG8_SCHED; PG8_LDA(At, 1, 0); PG8_STAGE(PG8_SA(0, 1), a2 + hstep, voffA);
            PG8_WAIT_V(8); PG8_WAIT_L(0); PG8_BAR; PG8_MMA(0, 0, At, B0); PG8_MMA(0, 1, At, B1); PG8_BAR; PG8_SCHED;
            PG8_LDA(At, 1, 1); PG8_STAGE(PG8_SB(1, 0), b3, voffB); PG8_STAGE(PG8_SB(1, 1), b3 + hstep, voffB); PG8_STAGE(PG8_SA(1, 0), a3, voffA);
            PG8_WAIT_V(8); PG8_WAIT_L(0); PG8_BAR; PG8_MMA(1, 0, At, B0); PG8_MMA(1, 1, At, B1); PG8_BAR; PG8_SCHED;
            } else {
            PG8_LDB(B0, 0, 0); PG8_SCHED; PG8_LDA(At, 0, 0); PG8_STAGE(PG8_SA(1, 1), a1 + hstep, voffA);
            PG8_WAIT_L(8); PG8_BAR; PG8_WAIT_L(0); PG8_MMA(0, 0, At, B0); PG8_BAR; PG8_SCHED;
            PG8_LDB(B1, 0, 1); PG8_STAGE(PG8_SB(0, 0), b2, voffB);
            PG8_BAR; PG8_WAIT_L(0); PG8_MMA(0, 1, At, B1); PG8_BAR;
            PG8_LDA(At, 0, 1); PG8_STAGE(PG8_SA(0, 0), a2, voffA);
            PG8_BAR; PG8_WAIT_L(0); PG8_MMA(1, 0, At, B0); PG8_BAR; PG8_SCHED;
            PG8_STAGE(PG8_SB(0, 1), b2 + hstep, voffB);
            PG8_WAIT_V(6); PG8_BAR; PG8_MMA(1, 1, At, B1); PG8_BAR;
            PG8_LDB(B0, 1, 0); PG8_SCHED; PG8_LDA(At, 1, 0); PG8_STAGE(PG8_SA(0, 1), a2 + hstep, voffA);
            PG8_WAIT_L(8); PG8_BAR; PG8_WAIT_L(0); PG8_MMA(0, 0, At, B0); PG8_BAR; PG8_SCHED;
            PG8_LDB(B1, 1, 1); PG8_STAGE(PG8_SB(1, 0), b3, voffB);
            PG8_BAR; PG8_WAIT_L(0); PG8_MMA(0, 1, At, B1); PG8_BAR;
            PG8_LDA(At, 1, 1); PG8_STAGE(PG8_SA(1, 0), a3, voffA);
            PG8_BAR; PG8_WAIT_L(0); PG8_MMA(1, 0, At, B0); PG8_BAR; PG8_SCHED;
            PG8_STAGE(PG8_SB(1, 1), b3 + hstep, voffB);
            PG8_WAIT_V(6); PG8_BAR; PG8_MMA(1, 1, At, B1); PG8_BAR;
            }
        }
        if constexpr (ALIGN_EPI) { if (wr == 0) PG8_BAR; }
        if constexpr (!Epi::AFTER_DRAIN) { E(acc, cur, wr, wc, fr, fq); S.done(cur); }
        if (!has_next) break;
#pragma unroll
        for (int a = 0; a < 2; ++a)
#pragma unroll
            for (int b = 0; b < 2; ++b)
#pragma unroll
                for (int m = 0; m < 4; ++m)
#pragma unroll
                    for (int n = 0; n < 2; ++n) acc[a][b][m][n] = (f32x4){0.f, 0.f, 0.f, 0.f};
        cur = nxt; cA = nA; cB = nB; ++ui;
        if constexpr (ALIGN_EPI) { if (wr == 1) PG8_BAR; }
    }
    PG8_WAIT_V(0);
    if constexpr (!ALIGN_EPI) { if (wr == 0) PG8_BAR; }
    PG8_BAR;
    if constexpr (Epi::AFTER_DRAIN) { E.fused(acc, cur, wr, wc, fr, fq, lds, wid, lane); S.done(cur); }
#undef PG8_SA
#undef PG8_SB
#undef PG8_STAGE
#undef PG8_LDA
#undef PG8_LDB
#undef PG8_MMA
#undef PG8_WAIT_V
#undef PG8_WAIT_L
#undef PG8_BAR
#undef PG8_SCHED
}
}

#ifndef PG8_SP2
#define PG8_SP2 true
#endif
#ifndef PG8_ALIGN
#define PG8_ALIGN true
#endif
#include <hip/hip_bf16.h>
#include <cmath>
#ifndef PH_REP
#define PH_REP 0
#endif
namespace attn_body {
using bf16=__hip_bfloat16;
using bf16x8=__attribute__((ext_vector_type(8)))short;
using s16x4=__attribute__((ext_vector_type(4)))short;
using f32x16=__attribute__((ext_vector_type(16)))float;
using u32x4=__attribute__((ext_vector_type(4)))unsigned;
constexpr int D=64;
constexpr int NW=8,QBLK=32,QB=QBLK*NW,KVBLK=64;
constexpr int ATTN_UNIT_ROWS=QB;
__device__ __forceinline__ int crow(int r,int hi){return (r&3)+8*(r>>2)+4*hi;}
#define SBAR() __builtin_amdgcn_sched_barrier(0)
__device__ __forceinline__ void cmask(f32x16&p0,f32x16&p1,int jb,int qrel,int hi){
  const float NEG=-INFINITY; int kb=64*jb+4*hi;
  #pragma unroll
  for(int r=0;r<16;++r){int kv=kb+(r&3)+8*(r>>2); if(kv>qrel)p0[r]=NEG; if(kv+32>qrel)p1[r]=NEG;}
}

__device__ __forceinline__ void wmask(f32x16&p0,f32x16&p1,unsigned long long w,int hi){
  const unsigned wl=((unsigned)w)>>(4*hi), wh=((unsigned)(w>>32))>>(4*hi);
  #pragma unroll
  for(int r=0;r<16;++r){ const int pr=(r&3)+8*(r>>2);
    const unsigned m0=(unsigned)(((int)(wl<<(31-pr)))>>31), m1=(unsigned)(((int)(wh<<(31-pr)))>>31);
    p0[r]=__uint_as_float((__float_as_uint(p0[r])&m0)|(0xFF800000u&~m0));
    p1[r]=__uint_as_float((__float_as_uint(p1[r])&m1)|(0xFF800000u&~m1)); }
}
constexpr int NSLOT=3, SLOTB=8192;
constexpr int LDS_K=0, LDS_V=NSLOT*SLOTB, LDS_WS=2*NSLOT*SLOTB, LDS_OST=LDS_WS+NW*64*4, LDS_BYTES=LDS_OST+NW*4096;
constexpr float C2=0.125f*1.4426950408889634f;
__device__ __forceinline__ void glds16(const void*gsrc,unsigned lds_dst){unsigned keep;
  asm volatile("s_mov_b32 %0, m0\n\ts_mov_b32 m0, %2\n\ts_nop 0\n\tglobal_load_lds_dwordx4 %1, off\n\ts_mov_b32 m0, %0":"=&s"(keep):"v"(gsrc),"s"(lds_dst):"memory");}
__device__ __forceinline__ float max3f(float a,float b,float c){float r;asm("v_max3_f32 %0, %1, %2, %3":"=v"(r):"v"(a),"v"(b),"v"(c));return r;}
__device__ __forceinline__ float max2f(float a,float b){float r;asm("v_max_f32_e32 %0, %1, %2":"=v"(r):"v"(a),"v"(b));return r;}
__device__ __forceinline__ float fadd_s(float a,float b){float r;asm("v_add_f32_e32 %0, %1, %2":"=v"(r):"v"(a),"v"(b));return r;}
__device__ __forceinline__ float fsub_s(float a,float b){float r;asm("v_sub_f32_e32 %0, %1, %2":"=v"(r):"v"(a),"v"(b));return r;}
typedef float f32x2_t __attribute__((ext_vector_type(2))); typedef __bf16 bf16x2_t __attribute__((ext_vector_type(2)));
__device__ __forceinline__ unsigned cvtpk_s(float lo,float hi){f32x2_t v={lo,hi};bf16x2_t b=__builtin_convertvector(v,bf16x2_t);return __builtin_bit_cast(unsigned,b);}
#define WAIT_BAR(N) asm volatile("s_waitcnt vmcnt(" #N ") lgkmcnt(0)\n\ts_barrier":::"memory")

__device__ __forceinline__ void qkt(f32x16&p0,f32x16&p1,const char*Kslot,const bf16x8*qr,const f32x16&negm,int r32,int hi){
  const char*kb=Kslot+hi*1024+r32*16;
  #pragma unroll
  for(int d0=0;d0<4;++d0){
    const bf16x8 b0=*reinterpret_cast<const bf16x8*>(kb+d0*2048);
    const bf16x8 b1=*reinterpret_cast<const bf16x8*>(kb+d0*2048+512);
    if(d0==0){p0=__builtin_amdgcn_mfma_f32_32x32x16_bf16(b0,qr[0],negm,0,0,0);p1=__builtin_amdgcn_mfma_f32_32x32x16_bf16(b1,qr[0],negm,0,0,0);}
    else{p0=__builtin_amdgcn_mfma_f32_32x32x16_bf16(b0,qr[d0],p0,0,0,0);p1=__builtin_amdgcn_mfma_f32_32x32x16_bf16(b1,qr[d0],p1,0,0,0);}}
}
typedef __attribute__((address_space(3))) const char* lds_cptr;
typedef short v4i16_t __attribute__((ext_vector_type(4)));
__device__ __forceinline__ void kload8(bf16x8*kf,lds_cptr kp){
  kf[0]=*(const __attribute__((address_space(3))) bf16x8*)(kp);      kf[1]=*(const __attribute__((address_space(3))) bf16x8*)(kp+512);
  kf[2]=*(const __attribute__((address_space(3))) bf16x8*)(kp+2048); kf[3]=*(const __attribute__((address_space(3))) bf16x8*)(kp+2560);
  kf[4]=*(const __attribute__((address_space(3))) bf16x8*)(kp+4096); kf[5]=*(const __attribute__((address_space(3))) bf16x8*)(kp+4608);
  kf[6]=*(const __attribute__((address_space(3))) bf16x8*)(kp+6144); kf[7]=*(const __attribute__((address_space(3))) bf16x8*)(kp+6656);
}
__device__ __forceinline__ void kload2(bf16x8*kf,lds_cptr kp,int j){ kf[2*j]=*(const __attribute__((address_space(3))) bf16x8*)(kp+j*2048); kf[2*j+1]=*(const __attribute__((address_space(3))) bf16x8*)(kp+j*2048+512); }
__device__ __forceinline__ s16x4 vtr(lds_cptr p){ return __builtin_bit_cast(s16x4,__builtin_amdgcn_ds_read_tr16_b64_v4i16((__attribute__((address_space(3))) v4i16_t*)p)); }
__device__ __forceinline__ float rowmax(const f32x16&p0,const f32x16&p1){
  float a=max3f(p0[0],p0[1],p1[0]),b=max3f(p0[2],p0[3],p1[1]);a=max3f(a,p1[2],p1[3]);
  #pragma unroll
  for(int r=4;r<16;r+=4){a=max3f(a,p0[r],p0[r+1]);b=max3f(b,p0[r+2],p0[r+3]);a=max3f(a,p1[r],p1[r+1]);b=max3f(b,p1[r+2],p1[r+3]);}
  const float m=max2f(a,b);
  auto rr=__builtin_amdgcn_permlane32_swap(__float_as_uint(m),__float_as_uint(m),false,false);
  return max2f(__uint_as_float(rr[0]),__uint_as_float(rr[1]));
}
__device__ __forceinline__ void pv(f32x16*o,int vb,bf16x8 pa0,bf16x8 pa1,bf16x8 pa2,bf16x8 pa3){
  #pragma unroll
  for(int d0=0;d0<2;++d0){s16x4 lo[4],hi[4];
    #pragma unroll
    for(int ks=0;ks<4;++ks){
      asm volatile("ds_read_b64_tr_b16 %0,%1 offset:%c2":"=&v"(lo[ks]):"v"(vb),"i"(d0*4096+ks*1024):"memory");
      asm volatile("ds_read_b64_tr_b16 %0,%1 offset:%c2":"=&v"(hi[ks]):"v"(vb),"i"(d0*4096+ks*1024+512):"memory");}
    asm volatile("s_waitcnt lgkmcnt(0)":::"memory");SBAR();
    #define PK(k) (bf16x8){lo[k][0],lo[k][1],lo[k][2],lo[k][3],hi[k][0],hi[k][1],hi[k][2],hi[k][3]}
    o[d0]=__builtin_amdgcn_mfma_f32_32x32x16_bf16(pa0,PK(0),o[d0],0,0,0);
    o[d0]=__builtin_amdgcn_mfma_f32_32x32x16_bf16(pa1,PK(1),o[d0],0,0,0);
    o[d0]=__builtin_amdgcn_mfma_f32_32x32x16_bf16(pa2,PK(2),o[d0],0,0,0);
    o[d0]=__builtin_amdgcn_mfma_f32_32x32x16_bf16(pa3,PK(3),o[d0],0,0,0);
    #undef PK
  }
}

#ifndef ATTN_STORE16
#define ATTN_STORE16(p,v) (*(u32x4*)(p)=(v))
#endif
template<int THRL,bool MASKED,int PQ,int PV,int PO,int SEQ> __device__ __forceinline__ void attn_unit(int b,int qcol,int vcol,int ocol,int qb,const bf16*Q,const bf16*__restrict__ K,const bf16*__restrict__ V,bf16*O,const unsigned long long*__restrict__ Wm,char*shm,const int tid){
  const int lane=tid&63,r32=lane&31,hi=lane>>5; const int wid=__builtin_amdgcn_readfirstlane(tid>>6);
  const long rowbase=(long)b*SEQ; const int q0=qb*QB;
  const bf16*Qw=Q+(rowbase+q0+wid*QBLK)*PQ+qcol;
  const bf16*Kh=K+rowbase*PQ+qcol,*Vh=V+rowbase*PV+vcol;
  const unsigned long long*Wrow=Wm+(rowbase+q0+wid*QBLK+r32)*64;
  const unsigned lds0=(unsigned)(uintptr_t)shm;
  float*wsf=(float*)(shm+LDS_WS)+wid*64;
  const bf16*ksrc=Kh+(long)lane*PQ+wid*8;
  const bf16*vsrc=Vh+(long)(16*(wid&3)+(lane>>2))*PV+(wid>>2)*32+(lane&3)*8;
  const unsigned kdst=lds0+LDS_K+wid*1024, vdst=lds0+LDS_V+wid*1024;
  #define DMA_K(t,slot) glds16(ksrc+(long)(t)*KVBLK*PQ,(unsigned)__builtin_amdgcn_readfirstlane(kdst+(slot)))
  #define DMA_V(t,slot) glds16(vsrc+(long)(t)*KVBLK*PV,(unsigned)__builtin_amdgcn_readfirstlane(vdst+(slot)))
  const int vb0=(int)(lds0+LDS_V)+((lane>>4)&1)*32+(lane&3)*8+(4*hi+((lane&15)>>2))*64;
  const char*Kbase=shm+LDS_K; bf16x8 kf[8];
  const lds_cptr shm3=(lds_cptr)shm; const lds_cptr kp0=shm3+LDS_K+hi*1024+r32*16; const lds_cptr vp0=shm3+LDS_V+((lane>>4)&1)*32+(lane&3)*8+(4*hi+((lane&15)>>2))*64;
  const int NT=(q0+QB)/KVBLK;
  DMA_K(0,0);DMA_V(0,0);DMA_K(1,SLOTB);
  bf16x8 qr[4];
  #pragma unroll
  for(int d0=0;d0<4;++d0)qr[d0]=*reinterpret_cast<const bf16x8*>(&Qw[(long)r32*PQ+d0*16+hi*8]);
  float mhat=0.f,l_reg=0.f;f32x16 o[2];o[0]=f32x16{};o[1]=f32x16{};const f32x16 zz=f32x16{};
  const int qrel=wid*QBLK+r32;
  #define CMASK(P0,P1,t) do{ if(MASKED){ wmask(P0,P1,wcur,hi); } else { int jb_=(t)-(NT-4); if(jb_>=0)cmask(P0,P1,jb_,qrel,hi); } }while(0)
  bool resc=false;
  #define START(P0,P1) do{ const float rm=rowmax(P0,P1); resc=false; \
    { const float dl=(MASKED&&rm==-INFINITY)?0.f:rm; mhat=fadd_s(mhat,dl); \
      _Pragma("unroll") for(int r=0;r<16;++r){P0[r]=fsub_s(P0[r],dl);P1[r]=fsub_s(P1[r],dl);} \
      } \
    _Pragma("unroll") for(int r=0;r<16;++r)P0[r]=__builtin_amdgcn_exp2f(P0[r]); }while(0)
  #define RESC() do{ if(resc){ asm volatile("s_waitcnt lgkmcnt(0)":::"memory"); \
      _Pragma("unroll") for(int d_=0;d_<2;++d_) _Pragma("unroll") for(int r=0;r<16;++r)o[d_][r]*=wsf[crow(r,hi)]; } }while(0)
  f32x16 pA0,pA1,pB0,pB1;
  int sl_prev=0,sl_cur=0,sl_next=SLOTB;
  #define ROT() do{sl_prev=sl_cur;sl_cur=sl_next;sl_next=(sl_next==(NSLOT-1)*SLOTB)?0:sl_next+SLOTB;}while(0)
  DMA_K(2,2*SLOTB);
  WAIT_BAR(3);
  { unsigned long long wcur=0ull; if(MASKED)wcur=Wrow[0];
    qkt(pA0,pA1,Kbase,qr,zz,r32,hi);asm volatile("s_nop 15\n\ts_nop 7":"+v"(pA0),"+v"(pA1));CMASK(pA0,pA1,0); }
  START(pA0,pA1);
  _Pragma("unroll") for(int r=0;r<16;++r)pA1[r]=__builtin_amdgcn_exp2f(pA1[r]);
  WAIT_BAR(0);
  DMA_K(3,0);DMA_V(1,SLOTB);
  ROT();
  kload8(kf,kp0+sl_cur);
  WAIT_BAR(2);
  s16x4 vlo[8],vhi[8]; u32x4 pw0,pw1,pw2,pw3;
  #define PKW(P,B) cvtpk_s(P[B],P[B+1])
  #define PAF(k) __builtin_bit_cast(bf16x8,pw##k)
  #define VFR(i) (bf16x8){vlo[i][0],vlo[i][1],vlo[i][2],vlo[i][3],vhi[i][0],vhi[i][1],vhi[i][2],vhi[i][3]}
  #define PIN(x) asm volatile("":"+v"(x))
  #define MX3(a,b,c) __builtin_fmaxf(__builtin_fmaxf((a),(b)),(c))
  #define GAPA(MF,A0,A1,A2,A3,W0,W1,PW) do{ MF; sacc+=A0; sacc+=A1; sacc+=A2; sacc+=A3; PIN(sacc); W0; W1; PIN(PW); SBAR(); }while(0)
  #define EX(v) __builtin_amdgcn_exp2f(v)
  #define GAPB(MF,X,B) do{ MF; X[B]=EX(X[B]-mhat); X[B+1]=EX(X[B+1]-mhat); X[B+2]=EX(X[B+2]-mhat); X[B+3]=EX(X[B+3]-mhat); PIN(X); SBAR(); }while(0)
  #define VRD(i) do{ vlo[i]=vtr(vp_+(((i)>>2)*4096+((i)&3)*1024)); vhi[i]=vtr(vp_+(((i)>>2)*4096+((i)&3)*1024+512)); }while(0)
  #define KRD(G,j) do{ if(G){ kload2(kf,kp0+sl_next,j); SBAR(); } }while(0)
  #define STEP(C0,C1,P0,P1,t,GK,GV,GL) do{ SBAR(); \
    unsigned long long wcur=0ull; if(MASKED){ wcur=Wrow[(t)]; SBAR(); } \
    const lds_cptr vp_=vp0+sl_prev; \
    VRD(0); SBAR(); float sacc=(P0[0]+P0[1]); \
    GAPA(C0=__builtin_amdgcn_mfma_f32_32x32x16_bf16(kf[0],qr[0],zz,0,0,0), P0[2],P0[3],P0[4],P0[5],     pw0[0]=PKW(P0,0), pw0[1]=PKW(P0,2), pw0); \
    VRD(4); SBAR(); GAPA(C1=__builtin_amdgcn_mfma_f32_32x32x16_bf16(kf[1],qr[0],zz,0,0,0), P0[6],P0[7],P0[8],P0[9],     pw0[2]=PKW(P0,4), pw0[3]=PKW(P0,6), pw0); \
    VRD(1); SBAR(); GAPA(C0=__builtin_amdgcn_mfma_f32_32x32x16_bf16(kf[2],qr[1],C0,0,0,0),   P0[10],P0[11],P0[12],P0[13], pw1[0]=PKW(P0,8), pw1[1]=PKW(P0,10), pw1); \
    VRD(5); SBAR(); GAPA(C1=__builtin_amdgcn_mfma_f32_32x32x16_bf16(kf[3],qr[1],C1,0,0,0),   P0[14],P0[15],P1[0],P1[1],   pw1[2]=PKW(P0,12),pw1[3]=PKW(P0,14), pw1); \
    VRD(2); SBAR(); GAPA(C0=__builtin_amdgcn_mfma_f32_32x32x16_bf16(kf[4],qr[2],C0,0,0,0),   P1[2],P1[3],P1[4],P1[5],     pw2[0]=PKW(P1,0), pw2[1]=PKW(P1,2), pw2); \
    VRD(6); SBAR(); GAPA(C1=__builtin_amdgcn_mfma_f32_32x32x16_bf16(kf[5],qr[2],C1,0,0,0),   P1[6],P1[7],P1[8],P1[9],     pw2[2]=PKW(P1,4), pw2[3]=PKW(P1,6), pw2); \
    VRD(3); SBAR(); GAPA(C0=__builtin_amdgcn_mfma_f32_32x32x16_bf16(kf[6],qr[3],C0,0,0,0),   P1[10],P1[11],P1[12],P1[13], pw3[0]=PKW(P1,8), pw3[1]=PKW(P1,10), pw3); \
    VRD(7); SBAR(); GAPA(C1=__builtin_amdgcn_mfma_f32_32x32x16_bf16(kf[7],qr[3],C1,0,0,0),   P1[14],P1[15],0.f,0.f,       pw3[2]=PKW(P1,12),pw3[3]=PKW(P1,14), pw3); \
    l_reg+=sacc; \
    if(!MASKED){ if(GK){DMA_K((t)+3,sl_cur);} if(GV){DMA_V((t)+1,sl_next);} } \
    CMASK(C0,C1,t); \
    if(MASKED){ if(GK){DMA_K((t)+3,sl_cur);} if(GV){DMA_V((t)+1,sl_next);} } \
    { float a=MX3(C0[0],C0[1],C1[0]),b=MX3(C0[2],C0[3],C1[1]); a=MX3(a,C1[2],C1[3]); \
      _Pragma("unroll") for(int r=4;r<16;r+=4){a=MX3(a,C0[r],C0[r+1]);b=MX3(b,C0[r+2],C0[r+3]);a=MX3(a,C1[r],C1[r+1]);b=MX3(b,C1[r+2],C1[r+3]);} \
      float rm=__builtin_fmaxf(a,b); { auto rr=__builtin_amdgcn_permlane32_swap(__float_as_uint(rm),__float_as_uint(rm),false,false); rm=__builtin_fmaxf(__uint_as_float(rr[0]),__uint_as_float(rr[1])); } \
      rm-=mhat; resc=false; \
      if(__builtin_expect(__any(rm>(float)THRL),0)){ const float dl=__builtin_fmaxf(rm,0.f); mhat+=dl; \
        const float f=__builtin_amdgcn_exp2f(-dl); l_reg*=f; if(hi==0)wsf[r32]=f; resc=true; } } \
    SBAR(); \
    GAPB(o[0]=__builtin_amdgcn_mfma_f32_32x32x16_bf16(PAF(0),VFR(0),o[0],0,0,0), C0,0); \
    GAPB(o[1]=__builtin_amdgcn_mfma_f32_32x32x16_bf16(PAF(0),VFR(4),o[1],0,0,0), C0,4); \
    KRD(GL,0); GAPB(o[0]=__builtin_amdgcn_mfma_f32_32x32x16_bf16(PAF(1),VFR(1),o[0],0,0,0), C0,8); \
    KRD(GL,1); GAPB(o[1]=__builtin_amdgcn_mfma_f32_32x32x16_bf16(PAF(1),VFR(5),o[1],0,0,0), C0,12); \
    KRD(GL,2); GAPB(o[0]=__builtin_amdgcn_mfma_f32_32x32x16_bf16(PAF(2),VFR(2),o[0],0,0,0), C1,0); \
    KRD(GL,3); GAPB(o[1]=__builtin_amdgcn_mfma_f32_32x32x16_bf16(PAF(2),VFR(6),o[1],0,0,0), C1,4); \
    GAPB(o[0]=__builtin_amdgcn_mfma_f32_32x32x16_bf16(PAF(3),VFR(3),o[0],0,0,0), C1,8); \
    GAPB(o[1]=__builtin_amdgcn_mfma_f32_32x32x16_bf16(PAF(3),VFR(7),o[1],0,0,0), C1,12); \
    }while(0)
  int t=1;
  #undef CMASK
  #define CMASK(P0,P1,t) do{ if(MASKED){ wmask(P0,P1,wcur,hi); } }while(0)
  for(;t+5<NT;t+=2){
    STEP(pB0,pB1,pA0,pA1,t,true,true,true);     WAIT_BAR(2); RESC(); ROT();
    STEP(pA0,pA1,pB0,pB1,t+1,true,true,true);   WAIT_BAR(2); RESC(); ROT();
  }
  #undef CMASK
  #define CMASK(P0,P1,t) do{ if(MASKED){ wmask(P0,P1,wcur,hi); } else { int jb_=(t)-(NT-4); if(jb_>=0)cmask(P0,P1,jb_,qrel,hi); } }while(0)
  #define ENDW(tt) do{ if((tt)+3<NT){WAIT_BAR(2);} else if((tt)+2<NT){WAIT_BAR(1);} else {WAIT_BAR(0);} }while(0)
  for(;t+1<NT;t+=2){
    STEP(pB0,pB1,pA0,pA1,t,(t+3<NT),(t+1<NT),(t+1<NT));       ENDW(t);   RESC(); ROT();
    STEP(pA0,pA1,pB0,pB1,t+1,(t+4<NT),(t+2<NT),(t+2<NT));     ENDW(t+1); RESC(); ROT();
  }
  STEP(pB0,pB1,pA0,pA1,NT-1,false,false,false); RESC();
  { float sacc=pB0[0]+pB0[1]; _Pragma("unroll") for(int r=2;r<16;++r)sacc+=pB0[r]; _Pragma("unroll") for(int r=0;r<16;++r)sacc+=pB1[r]; l_reg+=sacc;
    pw0=(u32x4){PKW(pB0,0),PKW(pB0,2),PKW(pB0,4),PKW(pB0,6)};pw1=(u32x4){PKW(pB0,8),PKW(pB0,10),PKW(pB0,12),PKW(pB0,14)};pw2=(u32x4){PKW(pB1,0),PKW(pB1,2),PKW(pB1,4),PKW(pB1,6)};pw3=(u32x4){PKW(pB1,8),PKW(pB1,10),PKW(pB1,12),PKW(pB1,14)};
    SBAR(); pv(o,vb0+sl_cur,PAF(0),PAF(1),PAF(2),PAF(3)); }
  #undef PKW
  #undef PAF
  #undef VFR
  #undef PIN
  #undef MX3
  #undef GAPA
  #undef GAPB
  #undef EX
  #undef VRD
  #undef KRD
  #undef STEP
  #undef ENDW
  {auto rr=__builtin_amdgcn_permlane32_swap(__float_as_uint(l_reg),__float_as_uint(l_reg),false,false);l_reg=__uint_as_float(rr[0])+__uint_as_float(rr[1]);}
  if(hi==0)wsf[32+r32]=l_reg;asm volatile("s_waitcnt lgkmcnt(0)":::"memory");
  float rli[16];
  #pragma unroll
  for(int r=0;r<16;++r)rli[r]=__builtin_amdgcn_rcpf(wsf[32+crow(r,hi)]);
  bf16*Ow=O+(rowbase+q0+wid*QBLK)*PO+ocol;
  { bf16*stg=(bf16*)(shm+LDS_OST)+wid*2048;
    #pragma unroll
    for(int r=0;r<16;++r){const int orow=crow(r,hi);
      #pragma unroll
      for(int d0=0;d0<2;++d0)stg[orow*64+d0*32+r32]=__float2bfloat16(o[d0][r]*rli[r]);}
    asm volatile("s_waitcnt lgkmcnt(0)":::"memory");
    #pragma unroll
    for(int i=0;i<4;++i){const int row=i*8+(lane>>3),ch=lane&7; const u32x4 v=*(const u32x4*)(stg+row*64+ch*8); ATTN_STORE16(Ow+(long)row*PO+ch*8,v);} }
  asm volatile("s_waitcnt lgkmcnt(0)\n\ts_barrier":::"memory");
  #undef DMA_K
  #undef DMA_V
  #undef CMASK
  #undef START
  #undef RESC
  #undef ROT
}
constexpr int ATTN_LDS_BYTES=LDS_BYTES;
struct AttnTensors { const bf16* Q; const bf16* K; const bf16* V; bf16* O; const unsigned long long* W; };
struct AttnUnit { int b, qcol, vcol, ocol, qb; };
struct DiffOrder {
  int vcu;
  __device__ __forceinline__ explicit DiffOrder(int v):vcu(v){}
  __device__ __forceinline__ bool next(int i,AttnUnit&u)const{ if(i>=((PH_REP&0x800)?8:4))return false; i&=3; const int st=vcu>>2,s=vcu&3,hc=(st>>1)&7,half=st&1;
    u.b=st>>4; u.qcol=hc*64; u.vcol=(hc>>1)*128+half*64; u.ocol=hc*128+half*64; u.qb=(i==0)?s:(i==1)?7-s:(i==2)?8+s:15-s; return true; }
};
struct DsaOrder {
  int vcu;
  __device__ __forceinline__ explicit DsaOrder(int v):vcu(v){}
  __device__ __forceinline__ bool next(int i,AttnUnit&u)const{ if(i>=2)return false; const int st=vcu>>3,s=vcu&7,h=st&7;
    u.b=st>>3; u.qcol=h*64; u.vcol=h*64; u.ocol=h*64; u.qb=(i==0)?s:15-s; return true; }
};
template<class Sched,bool MASKED,int PQ,int PV,int PO,int SEQ,int THRL=8> __device__ __forceinline__ void attn_phase(char*lds,const AttnTensors&T,const Sched&S,const int tid){
  AttnUnit u;
  for(int i=0;S.next(i,u);++i){ attn_unit<THRL,MASKED,PQ,PV,PO,SEQ>(u.b,u.qcol,u.vcol,u.ocol,u.qb,T.Q,T.K,T.V,T.O,T.W,lds,tid); }
}
#undef SBAR
#undef WAIT_BAR
}

#define GAS __attribute__((address_space(1)))
#define LAS __attribute__((address_space(3)))
typedef unsigned short bf16;
typedef unsigned v4u __attribute__((ext_vector_type(4)));
typedef float f32x4 __attribute__((ext_vector_type(4)));
typedef short bf16x8 __attribute__((ext_vector_type(8)));
typedef GAS unsigned gu32;
typedef GAS unsigned long long gu64;
#define RLX_AGENT __ATOMIC_RELAXED, __HIP_MEMORY_SCOPE_AGENT
#define LDS_WAIT() asm volatile("s_waitcnt lgkmcnt(0)" ::: "memory")
#define VM_WAIT() asm volatile("s_waitcnt vmcnt(0)" ::: "memory")
__device__ __forceinline__ unsigned long long rt() { return __builtin_amdgcn_s_memrealtime(); }
__device__ __forceinline__ unsigned f2bf(float f) { unsigned u = __builtin_bit_cast(unsigned, f); return (u + 0x7fffu + ((u >> 16) & 1u)) >> 16; }
__device__ __forceinline__ unsigned pk2(float lo, float hi) { return f2bf(lo) | (f2bf(hi) << 16); }

#define XB_TMO      128
#define XB_XCNT(j)  (256  + 64 * (j))
#define XB_XSUB(j)  (1280 + 64 * (j))
#define XB_XGEN(j)  (2304 + 64 * (j))
#define XB_TOP      3328
#define XB_TOPGEN   3392
#define XCD_BAR_WORDS 3456
#define XB_SPIN_CAP (1u << 18)

__device__ __forceinline__ unsigned xb_ld(unsigned* p)              { return __hip_atomic_load(p, __ATOMIC_RELAXED, __HIP_MEMORY_SCOPE_AGENT); }
__device__ __forceinline__ unsigned xb_add(unsigned* p, unsigned v) { return __hip_atomic_fetch_add(p, v, __ATOMIC_RELAXED, __HIP_MEMORY_SCOPE_AGENT); }
__device__ __forceinline__ unsigned xb_xcc_id() { return (unsigned)__builtin_amdgcn_s_getreg((3 << 11) | 20) & 0xFu; }
#define XB_SPIN(cond, bar) do { unsigned _sp = 0; while (cond) { __builtin_amdgcn_s_sleep(1); \
    if ((++_sp & 255u) == 0u) { if (xb_ld(&(bar)[XB_TMO])) break; if (_sp > XB_SPIN_CAP) { atomicAdd(&(bar)[XB_TMO], 1u); break; } } } } while (0)

struct XcdBarrier {
    unsigned* bar; unsigned x;
    volatile LAS unsigned* st;
};

__device__ __forceinline__ XcdBarrier xcd_barrier_post(unsigned* bar, volatile LAS unsigned* st, const int tid) {
    XcdBarrier b; b.bar = bar; b.x = xb_xcc_id(); b.st = st;
    if (tid == 0) (void)xb_add(&bar[XB_XCNT(b.x)], 1u);
    return b;
}
__device__ __forceinline__ void xcd_barrier_complete(unsigned* bar, unsigned x, unsigned& nloc, unsigned& nx) {
    const unsigned G = 256u;
    unsigned sum, cnt, mine, sp = 0u;
    for (;;) {
        sum = 0u; cnt = 0u; mine = 0u;
#pragma unroll
        for (unsigned j = 0; j < 16; ++j) { const unsigned c = xb_ld(&bar[XB_XCNT(j)]); sum += c; cnt += (c > 0u) ? 1u : 0u; mine = (j == x) ? c : mine; }
        if (sum == G) break;
        __builtin_amdgcn_s_sleep(1);
        if ((++sp & 255u) == 0u) { if (xb_ld(&bar[XB_TMO])) break; if (sp > XB_SPIN_CAP) { atomicAdd(&bar[XB_TMO], 1u); break; } }
    }
    nloc = mine > 0u ? mine : 1u; nx = cnt > 0u ? cnt : 1u;
}

__device__ __forceinline__ void xcd_barrier(const XcdBarrier& b, const int tid) {
    asm volatile("s_waitcnt vmcnt(0)" ::: "memory");
    __syncthreads();
    if (tid == 0) {
        unsigned* bar = b.bar;
        __builtin_amdgcn_s_waitcnt(0);
        unsigned nloc = b.st[0], nx = b.st[1];
        if (nloc == 0u) { xcd_barrier_complete(bar, b.x, nloc, nx); b.st[0] = nloc; b.st[1] = nx; }
        const unsigned old = xb_add(&bar[XB_XSUB(b.x)], 1u);
        const unsigned gen = old / nloc;
        if (old + 1u == (gen + 1u) * nloc) {
            __builtin_amdgcn_fence(__ATOMIC_RELEASE, "agent");
            asm volatile("s_waitcnt vmcnt(0)" ::: "memory");
            const unsigned og = xb_add(&bar[XB_TOP], 1u);
            const unsigned tg = og / nx;
            if (og + 1u == (tg + 1u) * nx) xb_add(&bar[XB_TOPGEN], 1u);
            else XB_SPIN(xb_ld(&bar[XB_TOPGEN]) == tg, bar);
            __builtin_amdgcn_fence(__ATOMIC_ACQUIRE, "agent");
            xb_add(&bar[XB_XGEN(b.x)], 1u);
            asm volatile("s_waitcnt vmcnt(0)" ::: "memory");
        } else {
            XB_SPIN(xb_ld(&bar[XB_XGEN(b.x)]) == gen, bar);
            __builtin_amdgcn_fence(__ATOMIC_ACQUIRE, "agent");
            asm volatile("s_waitcnt vmcnt(0)" ::: "memory");
        }
    }
    __syncthreads();
}
#ifndef PH_REP
#define PH_REP 0
#endif
constexpr int NWAVES = 8, GRID = 256;
constexpr int BATCH = 4, SEQ = 4096, D = 1024, M = BATCH * SEQ, FF = 4096, INW = 3656, NIN = 3840, NMOD = 6 * D;
constexpr float C2 = 0.125f * 1.4426950408889634f;
constexpr size_t MiB = 1u << 20;
constexpr size_t WS_CTL = 0, CTL_ZERO_BYTES = 1 * MiB;
constexpr size_t WS_MOD = 1 * MiB;
constexpr size_t WS_WIN = 2 * MiB, WS_WOUT = 10 * MiB, WS_W1 = 12 * MiB, WS_W2 = 20 * MiB;
constexpr size_t WS_COS = 28 * MiB, WS_SIN = 30 * MiB;
constexpr size_t WS_QKV = 32 * MiB;
constexpr size_t WS_ODIFF = 144 * MiB;
constexpr size_t WS_MIX = 176 * MiB;
constexpr size_t WS_XN = 208 * MiB;
constexpr size_t WS_RAW = 240 * MiB, WS_IK = 245 * MiB, WS_IW = 247 * MiB;
constexpr size_t WS_WM = 248 * MiB;
constexpr size_t WS_H = 32 * MiB;
constexpr size_t WS_END = 256 * MiB;
static_assert(WS_H + (size_t)M * FF * 2 <= WS_MIX && WS_WM + (size_t)M * 64 * 8 <= WS_END && WS_RAW + (size_t)M * 80 * 4 <= WS_IK, "d_ws map");
constexpr int CW_BAR = 4096;
constexpr int RING_OFF = 0, RING_BYTES = 135168;
constexpr int LDSCTL_OFF = RING_BYTES, MISC_OFF = LDSCTL_OFF + 320;
constexpr int LDS_BYTES = 147456;
static_assert(MISC_OFF + 128 <= LDS_BYTES && pg8::STAGE_BYTES <= RING_BYTES && attn_body::ATTN_LDS_BYTES <= RING_BYTES, "LDS map");

struct Frame {
    LAS unsigned char* lds; volatile LAS unsigned* MISC; gu32* ctl;
    int tid, lane, wave, vcu, G;
};

__device__ __forceinline__ float wave_sum(float v) {
#pragma unroll
    for (int o = 1; o < 64; o <<= 1) v += __shfl_xor(v, o);
    return v;
}
__device__ __forceinline__ int wave_sum_i(int v) {
#pragma unroll
    for (int o = 1; o < 64; o <<= 1) v += __shfl_xor(v, o);
    return v;
}

__device__ __forceinline__ int unperm64(int p) { const int g = p >> 5, fq = (p >> 3) & 3, e = p & 7; return 16 * g + 4 * fq + (e & 3) + 32 * (e >> 2); }
__device__ __forceinline__ int perm64(int d) { const int half = d >> 5, j = d & 31; return 32 * (j >> 4) + 8 * ((j >> 2) & 3) + (j & 3) + 4 * half; }
__device__ __forceinline__ int orig_col(int c) {
    if (c < 2048) { if ((c >> 9) == 2) return c; return (c & ~63) + unperm64(c & 63); }
    if (c < 2304) { const int r = c - 2048; return r < 72 ? 2048 + r : -1; }
    const int cc = c - 2304; if ((cc >> 9) == 2) return 2120 + cc; return 2120 + (cc & ~63) + unperm64(cc & 63);
}

template <bool MAPPED>
__device__ __forceinline__ void p0_transpose_item(const float* W, int K, int N, int NP_, bf16* WT, LAS float* scr, int item, int lane) {
    const int nblk = NP_ / 32, kb = item / nblk, nb = item % nblk, k0 = 64 * kb, n0 = 32 * nb;
    const int src = MAPPED ? orig_col(n0 + (lane & 31)) : (n0 + (lane & 31));
#pragma unroll 8
    for (int i = 0; i < 32; ++i) { const int kk = 2 * i + (lane >> 5); scr[kk * 33 + (lane & 31)] = src >= 0 ? W[(size_t)(k0 + kk) * N + src] : 0.f; }
    LDS_WAIT(); asm volatile("" ::: "memory");
    const int c = lane & 7;
#pragma unroll
    for (int j = 0; j < 4; ++j) { const int n = (lane >> 3) + 8 * j; const LAS float* s = scr + (8 * c) * 33 + n;
        v4u o; o.x = pk2(s[0 * 33], s[1 * 33]); o.y = pk2(s[2 * 33], s[3 * 33]); o.z = pk2(s[4 * 33], s[5 * 33]); o.w = pk2(s[6 * 33], s[7 * 33]);
        *(GAS v4u*)(WT + (size_t)(n0 + n) * K + k0 + 8 * c) = o; }
    LDS_WAIT(); asm volatile("" ::: "memory");
}

struct Ptrs {
    const float *x, *c, *w_ada, *b_ada, *norm1_w, *w_in, *lnw, *lnb, *lq1, *lk1, *lq2, *lk2, *subln, *w_out, *norm2_w, *w_ff1, *w_ff2, *norm_f;
    const int* pos; float* out;
    float *mod, *cosT, *sinT, *raw, *iw;
    bf16 *Win, *Wout, *W1, *W2, *QKV, *ODIFF, *MIX, *XN, *IK, *H;
    unsigned long long* WM;
};

__device__ __forceinline__ void p0a(Frame& F, const Ptrs& P) {
    LAS float* sil = (LAS float*)(F.lds + RING_OFF);
    LAS float* red = (LAS float*)(F.lds + RING_OFF + 16384);
    for (int i = F.tid; i < 4096; i += NWAVES * 64) { const float v = P.c[i]; sil[i] = v / (1.f + __expf(-v)); }
    __syncthreads();
    for (int item = F.vcu; item < NMOD / 32; item += F.G) {
        const int jl = F.tid & 31, kp = F.tid >> 5, j = item * 32 + jl;
        float a0 = 0.f, a1 = 0.f, a2 = 0.f, a3 = 0.f;
#pragma unroll 8
        for (int k = kp; k < D; k += 16) { const float w = P.w_ada[(size_t)k * NMOD + j]; a0 += sil[k] * w; a1 += sil[1024 + k] * w; a2 += sil[2048 + k] * w; a3 += sil[3072 + k] * w; }
        red[(kp * 4 + 0) * 32 + jl] = a0; red[(kp * 4 + 1) * 32 + jl] = a1; red[(kp * 4 + 2) * 32 + jl] = a2; red[(kp * 4 + 3) * 32 + jl] = a3;
        __syncthreads();
        if (F.tid < 128) { const int b = F.tid >> 5; float s = 0.f;
#pragma unroll
            for (int q = 0; q < 16; ++q) s += red[(q * 4 + b) * 32 + jl];
            P.mod[b * NMOD + j] = s + P.b_ada[j]; }
        __syncthreads();
    }
    {   const int e0 = F.vcu * (NWAVES * 64) + F.tid; const int j = e0 & 31;
        const float inv = (float)pow(10000.0, -(double)j / 32.0);
        for (int e = e0; e < M * 32; e += GRID * NWAVES * 64) {
            const float ang = (float)P.pos[e >> 5] * inv; float sn, cs; sincosf(ang, &sn, &cs);
            P.cosT[e] = cs; P.sinT[e] = sn;
        }
    }
    LAS float* scr = (LAS float*)(F.lds + RING_OFF + F.wave * 16384);
    const int gw = F.vcu * NWAVES + F.wave, NGW = F.G * NWAVES;
    constexpr int I_IN = (D / 64) * (NIN / 32), I_O = (D / 64) * (D / 32), I_1 = (D / 64) * (FF / 32), I_2 = (FF / 64) * (D / 32);
    constexpr int NITEMS = I_IN + I_O + I_1 + I_2;
    for (int it = gw; it < NITEMS; it += NGW) {
        int r = it;
        if (r < I_IN) { p0_transpose_item<true>(P.w_in, D, INW, NIN, P.Win, scr, r, F.lane); continue; } r -= I_IN;
        if (r < I_O) { p0_transpose_item<false>(P.w_out, D, D, D, P.Wout, scr, r, F.lane); continue; } r -= I_O;
        if (r < I_1) { p0_transpose_item<false>(P.w_ff1, D, FF, FF, P.W1, scr, r, F.lane); continue; } r -= I_1;
        p0_transpose_item<false>(P.w_ff2, FF, D, D, P.W2, scr, r, F.lane);
    }
}

__device__ __forceinline__ void mod_row(Frame& F, const float* xrow, bf16* orow, const float* nw, const float* sc, const float* sh) {
    const GAS f32x4* xr = (const GAS f32x4*)xrow + F.lane;
    f32x4 v[4]; float s = 0.f;
#pragma unroll
    for (int j = 0; j < 4; ++j) { v[j] = xr[64 * j]; s += (v[j].x * v[j].x + v[j].y * v[j].y) + (v[j].z * v[j].z + v[j].w * v[j].w); }
    const float rstd = 1.0f / sqrtf(wave_sum(s) * (1.f / D) + 1e-6f);
    GAS unsigned long long* o8 = (GAS unsigned long long*)orow + F.lane;
#pragma unroll
    for (int j = 0; j < 4; ++j) {
        const f32x4 g = ((const GAS f32x4*)nw)[F.lane + 64 * j], a = ((const GAS f32x4*)sc)[F.lane + 64 * j], b = ((const GAS f32x4*)sh)[F.lane + 64 * j];
        const f32x4 h = (v[j] * rstd * g) * (a + 1.0f) + b;
        o8[64 * j] = (unsigned long long)pk2(h.x, h.y) | ((unsigned long long)pk2(h.z, h.w) << 32);
    }
}
__device__ __forceinline__ void norm_mod_pass(Frame& F, const Ptrs& P, const float* src, const float* nw, int sc_off, int sh_off) {
    const int gw = F.vcu * NWAVES + F.wave, NGW = F.G * NWAVES, per = M / NGW;
    for (int i = 0; i < per; ++i) { const int m = gw * per + i; const int b = m / SEQ;
        mod_row(F, src + (size_t)m * D, P.XN + (size_t)m * D, nw, P.mod + b * NMOD + sc_off, P.mod + b * NMOD + sh_off); }
}
__device__ __forceinline__ void final_norm_pass(Frame& F, const Ptrs& P) {
    const int gw = F.vcu * NWAVES + F.wave, NGW = F.G * NWAVES, per = M / NGW;
    for (int i = 0; i < per; ++i) { const int m = gw * per + i;
        GAS f32x4* xr = (GAS f32x4*)(P.out + (size_t)m * D) + F.lane;
        f32x4 v[4]; float s = 0.f;
#pragma unroll
        for (int j = 0; j < 4; ++j) { v[j] = xr[64 * j]; s += (v[j].x * v[j].x + v[j].y * v[j].y) + (v[j].z * v[j].z + v[j].w * v[j].w); }
        const float rstd = 1.0f / sqrtf(wave_sum(s) * (1.f / D) + 1e-6f);
#pragma unroll
        for (int j = 0; j < 4; ++j) { const f32x4 g = ((const GAS f32x4*)P.norm_f)[F.lane + 64 * j]; xr[64 * j] = v[j] * rstd * g; }
    }
}
__device__ __forceinline__ void ik_pass(Frame& F, const Ptrs& P) {
    const int gw = F.vcu * NWAVES + F.wave, NGW = F.G * NWAVES, per = M / NGW;
    const float lw = P.lnw[F.lane], lb = P.lnb[F.lane];
    for (int i = 0; i < per; ++i) { const int m = gw * per + i;
        const float v = P.raw[(size_t)m * 80 + F.lane];
        const float mu = wave_sum(v) * (1.f / 64.f); const float dv = v - mu;
        const float var = wave_sum(dv * dv) * (1.f / 64.f);
        const float y = dv * (1.0f / sqrtf(var + 1e-5f)) * lw + lb;
        const float other = __shfl_xor(y, 32);
        const int j = F.lane & 31; const float cs = P.cosT[(size_t)m * 32 + j], sn = P.sinT[(size_t)m * 32 + j];
        const float o = F.lane < 32 ? y * cs - other * sn : y * cs + other * sn;
        P.IK[(size_t)m * 64 + perm64(F.lane)] = (bf16)f2bf(o);
        if (F.lane < 8) P.iw[(size_t)m * 8 + F.lane] = P.raw[(size_t)m * 80 + 64 + F.lane] * (0.35355339059327373f * 0.125f);
    }
}
__device__ __forceinline__ void diff_combine_pass(Frame& F, const Ptrs& P) {
    const int gw = F.vcu * NWAVES + F.wave, NGW = F.G * NWAVES, per = M / NGW;
    const float s1 = wave_sum(P.lq1[F.lane] * P.lk1[F.lane]), s2 = wave_sum(P.lq2[F.lane] * P.lk2[F.lane]);
    const float lam = __expf(s1) - __expf(s2) + 0.2f;
    const float g0 = P.subln[2 * F.lane] * 0.8f, g1 = P.subln[2 * F.lane + 1] * 0.8f;
    for (int i = 0; i < per; ++i) { const int m = gw * per + i;
        const GAS unsigned* od = (const GAS unsigned*)(P.ODIFF + (size_t)m * D);
        GAS unsigned* mx = (GAS unsigned*)(P.MIX + (size_t)m * D + 512);
#pragma unroll
        for (int h = 0; h < 4; ++h) {
            const unsigned a = od[(h * 2 + 0) * 64 + F.lane], b = od[(h * 2 + 1) * 64 + F.lane];
            const float v0 = __uint_as_float(a << 16) - lam * __uint_as_float(b << 16), v1 = __uint_as_float(a & 0xFFFF0000u) - lam * __uint_as_float(b & 0xFFFF0000u);
            const float r = 1.0f / sqrtf(wave_sum(v0 * v0 + v1 * v1) * (1.f / 128.f) + 1e-6f);
            mx[h * 64 + F.lane] = pk2(v0 * r * g0, v1 * r * g1);
        }
    }
}

constexpr int SEL_ROWB = 8200;
typedef unsigned short u16x2 __attribute__((ext_vector_type(2)));
#define OPAQUE_S(x) asm volatile("" : "+s"(x))
__device__ __forceinline__ unsigned cnt_lt2(unsigned code, unsigned candpair) {
    unsigned d;
    asm("v_pk_sub_u16 %0, %1, %2 clamp\n\tv_pk_min_u16 %0, %0, %3" : "=&v"(d) : "s"(candpair), "v"(code), "s"(0x00010001u));
    return d;
}
__device__ __forceinline__ unsigned sortable2(unsigned bits) { return bits ^ (((bits & 0x80008000u) >> 15) * 0x7FFFu + 0x80008000u); }
__device__ __forceinline__ int wave_total_i(int v) {
    v += __builtin_amdgcn_update_dpp(0, v, 0xB1, 0xF, 0xF, true);
    v += __builtin_amdgcn_update_dpp(0, v, 0x4E, 0xF, 0xF, true);
    v += __builtin_amdgcn_update_dpp(0, v, 0x124, 0xF, 0xF, true);
    v += __builtin_amdgcn_update_dpp(0, v, 0x128, 0xF, 0xF, true);
    return __builtin_amdgcn_readlane(v, 0) + __builtin_amdgcn_readlane(v, 16) + __builtin_amdgcn_readlane(v, 32) + __builtin_amdgcn_readlane(v, 48);
}
__device__ __forceinline__ int count_lt_both(const unsigned (&c0)[32], const unsigned (&c1)[32], int NPG, unsigned t0, unsigned t1) {
    const unsigned cp0 = t0 | (t0 << 16), cp1 = t1 | (t1 << 16); unsigned a0 = 0u, a1 = 0u; OPAQUE_S(NPG);
#pragma unroll
    for (int g = 0; g < 8; ++g) if (g < NPG) {
#pragma unroll
        for (int j = 0; j < 4; ++j) { a0 += cnt_lt2(c0[4 * g + j], cp0); a1 += cnt_lt2(c1[4 * g + j], cp1); } }
    const int l0 = (int)((a0 & 0xFFFFu) + (a0 >> 16)), l1 = (int)((a1 & 0xFFFFu) + (a1 >> 16));
    return wave_total_i(l0 | (l1 << 16));
}
__device__ __forceinline__ int tie_kappa(const unsigned (&code)[32], int NPG, unsigned T, int need) {
    int running = 0, kappa = 4095; bool found = false; OPAQUE_S(NPG);
#pragma unroll
    for (int g = 0; g < 8; ++g) if (g < NPG) {
#pragma unroll
        for (int j = 0; j < 4; ++j) {
#pragma unroll
            for (int hf = 0; hf < 2; ++hf) { const int p = 4 * g + j;
                const unsigned v = hf ? (code[p] >> 16) : (code[p] & 0xFFFFu);
                unsigned long long mm = __ballot(v == T);
                if (!found) { const int c = __popcll(mm);
                    if (running + c >= need) { int n = need - running; while (--n > 0) mm &= mm - 1ull; kappa = 128 * p + 64 * hf + (__ffsll((long long)mm) - 1); found = true; }
                    else running += c; }
                __builtin_amdgcn_sched_barrier(0);
            } } }
    return kappa;
}
__device__ __forceinline__ unsigned long long sel_words(const unsigned (&code)[32], int NPG, unsigned T, int kappa, int t, int lane) {
    unsigned wlo = 0u, whi = 0u; OPAQUE_S(NPG);
    const bool notie = (kappa == 4095);
#pragma unroll
    for (int g = 0; g < 8; ++g) if (g < NPG) {
#pragma unroll
        for (int j = 0; j < 4; ++j) {
#pragma unroll
            for (int hf = 0; hf < 2; ++hf) { const int p = 4 * g + j;
                const unsigned v = hf ? (code[p] >> 16) : (code[p] & 0xFFFFu);
                unsigned long long mm;
                if (notie) mm = __ballot(v >= T);
                else { const int key = 128 * p + 64 * hf + lane; mm = __ballot((key <= t) && ((v > T) || (v == T && key <= kappa))); }
                if (lane == 2 * p + hf) { wlo = (unsigned)mm; whi = (unsigned)(mm >> 32); }
                __builtin_amdgcn_sched_barrier(0);
            } } }
    return (unsigned long long)wlo | ((unsigned long long)whi << 32);
}
__device__ __forceinline__ void sel_unit(Frame& F, const Ptrs& P, int b, int qb) {
    const int q0 = qb * 16, lane = F.lane, wave = F.wave; const size_t rowb = (size_t)b * SEQ;
    unsigned long long* Wout = P.WM + (rowb + q0) * 64;
    if (q0 < 256) {
#pragma unroll
        for (int qq = 0; qq < 2; ++qq) { const int t = q0 + 2 * wave + qq, dt = t >> 6, rem = t & 63;
            const unsigned long long full = ~0ull, part = rem == 63 ? full : ((1ull << (rem + 1)) - 1ull);
            Wout[(2 * wave + qq) * 64 + lane] = lane < dt ? full : (lane == dt ? part : 0ull); }
        return;
    }
    LAS unsigned char* S = F.lds + RING_OFF;
    for (int rs_ = 0; rs_ <= ((PH_REP >> 13) & 1); ++rs_) {
        const int qn = lane & 15, kq = lane >> 4;
        const bf16* iqp = P.QKV + (size_t)3 * M * 512 + (rowb + q0 + qn) * 512 + kq * 8;
        bf16x8 qf[8][2]; float wq[8];
#pragma unroll
        for (int h = 0; h < 8; ++h) { qf[h][0] = *(const bf16x8*)(iqp + h * 64); qf[h][1] = *(const bf16x8*)(iqp + h * 64 + 32); wq[h] = P.iw[(rowb + q0 + qn) * 8 + h]; }
        const int NS = qb + 1;
        const bf16* ikp = P.IK + (rowb + qn) * 64 + kq * 8;
        const int nb = (NS - wave + NWAVES - 1) / NWAVES;
        bf16x8 kc[4][2], kn[4][2];
#pragma unroll
        for (int j = 0; j < 4; ++j) { const int ii = j < nb ? j : nb - 1; const bf16* p_ = ikp + (size_t)(wave + NWAVES * ii) * 1024; kc[j][0] = *(const bf16x8*)p_; kc[j][1] = *(const bf16x8*)(p_ + 32); }
#pragma unroll 1
        for (int i0 = 0; i0 < nb; i0 += 4) {
#pragma unroll
            for (int j = 0; j < 4; ++j) { int ii = i0 + 4 + j; ii = ii < nb ? ii : nb - 1; const bf16* p_ = ikp + (size_t)(wave + NWAVES * ii) * 1024; kn[j][0] = *(const bf16x8*)p_; kn[j][1] = *(const bf16x8*)(p_ + 32); }
#pragma unroll
            for (int j = 0; j < 4; ++j) if (i0 + j < nb) {
                const int s = wave + NWAVES * (i0 + j);
                f32x4 I = {0.f, 0.f, 0.f, 0.f};
#pragma unroll
                for (int h = 0; h < 8; ++h) {
                    f32x4 x = __builtin_amdgcn_mfma_f32_16x16x32_bf16(kc[j][0], qf[h][0], (f32x4){0.f, 0.f, 0.f, 0.f}, 0, 0, 0);
                    x = __builtin_amdgcn_mfma_f32_16x16x32_bf16(kc[j][1], qf[h][1], x, 0, 0, 0);
#pragma unroll
                    for (int i = 0; i < 4; ++i) I[i] += wq[h] * __builtin_amdgcn_fmed3f(x[i], 0.f, __builtin_inff());
                }
                unsigned h16[4];
#pragma unroll
                for (int i = 0; i < 4; ++i) { const _Float16 hv = (_Float16)I[i]; h16[i] = (unsigned)__builtin_bit_cast(unsigned short, hv); }
                if (s == NS - 1) {
#pragma unroll
                    for (int i = 0; i < 4; ++i) if (4 * kq + i > qn) h16[i] = 0xFC00u;
                }
                const unsigned long long pk = (unsigned long long)(h16[0] | (h16[1] << 16)) | ((unsigned long long)(h16[2] | (h16[3] << 16)) << 32);
                *(LAS unsigned long long*)(S + qn * SEL_ROWB + 2 * (16 * s + 4 * kq)) = pk;
            }
#pragma unroll
            for (int j = 0; j < 4; ++j) { kc[j][0] = kn[j][0]; kc[j][1] = kn[j][1]; }
        }
    }
    __syncthreads();
    for (int rq_ = 0; rq_ <= ((PH_REP >> 14) & 1); ++rq_) {
        const int nk = q0 + 16; int NPG = __builtin_amdgcn_readfirstlane((nk + 511) >> 9); const int TOT = NPG * 512;
        int ln = lane; asm volatile("" : "+v"(ln)); OPAQUE_S(NPG);
        unsigned c0[32], c1[32];
        const LAS unsigned char* r0 = S + (2 * wave) * SEL_ROWB; const LAS unsigned char* r1 = r0 + SEL_ROWB;
#pragma unroll
        for (int g = 0; g < 8; ++g) {
            if (g < NPG) {
#pragma unroll
                for (int j = 0; j < 4; ++j) { const int p = 4 * g + j; const int klo = 128 * p + ln, khi = klo + 64;
                    const unsigned a0 = *(const LAS unsigned short*)(r0 + 2 * klo), b0 = *(const LAS unsigned short*)(r0 + 2 * khi);
                    const unsigned a1 = *(const LAS unsigned short*)(r1 + 2 * klo), b1 = *(const LAS unsigned short*)(r1 + 2 * khi);
                    const unsigned lo0 = klo < nk ? a0 : 0xFC00u, hi0 = khi < nk ? b0 : 0xFC00u, lo1 = klo < nk ? a1 : 0xFC00u, hi1 = khi < nk ? b1 : 0xFC00u;
                    c0[p] = sortable2(lo0 | (hi0 << 16)); c1[p] = sortable2(lo1 | (hi1 << 16)); }
            } else {
#pragma unroll
                for (int j = 0; j < 4; ++j) { c0[4 * g + j] = 0x03FF03FFu; c1[4 * g + j] = 0x03FF03FFu; }
            }
        }
        unsigned T0 = 0u, T1 = 0u;
#pragma unroll 1
        for (int bit = 15; bit >= 0; --bit) {
            const unsigned n0 = T0 | (1u << bit), n1 = T1 | (1u << bit);
            const int both = count_lt_both(c0, c1, NPG, n0, n1);
            if (TOT - (both & 0xFFFF) >= 256) T0 = n0;
            if (TOT - (both >> 16) >= 256) T1 = n1;
        }
        const int ge = count_lt_both(c0, c1, NPG, T0, T1), gt = count_lt_both(c0, c1, NPG, T0 + 1u, T1 + 1u);
        const int ge0 = TOT - (ge & 0xFFFF), ge1 = TOT - (ge >> 16), gt0 = TOT - (gt & 0xFFFF), gt1 = TOT - (gt >> 16);
        const int need0 = 256 - gt0, need1 = 256 - gt1;
        int kap0 = 4095, kap1 = 4095;
        if (ge0 - gt0 > need0) kap0 = tie_kappa(c0, NPG, T0, need0);
        if (ge1 - gt1 > need1) kap1 = tie_kappa(c1, NPG, T1, need1);
        const int t0 = q0 + 2 * wave;
        Wout[(2 * wave) * 64 + lane] = sel_words(c0, NPG, T0, kap0, t0, ln);
        Wout[(2 * wave + 1) * 64 + lane] = sel_words(c1, NPG, T1, kap1, t0 + 1, ln);
    }
    __syncthreads();
}

struct Args { const void* in[19]; float* out; unsigned char* ws; int ph_lo, ph_hi; };
constexpr int N_PHASES = 11;
template <class T> __device__ __forceinline__ T* as_g(const void* p) { GAS T* g = (GAS T*)(T*)p; asm volatile("" : "+s"(g)); return (T*)g; }
#define AS_G(T, p) as_g<T>(p)
typedef const __attribute__((address_space(4))) Args* KArgs;
__device__ __forceinline__ void fill_ptrs(Ptrs& P, KArgs ka) {
    unsigned char* ws = AS_G(unsigned char, ka->ws);
    P.x = AS_G(const float, ka->in[0]); P.c = AS_G(const float, ka->in[1]); P.pos = AS_G(const int, ka->in[2]); P.w_ada = AS_G(const float, ka->in[3]); P.b_ada = AS_G(const float, ka->in[4]);
    P.norm1_w = AS_G(const float, ka->in[5]); P.w_in = AS_G(const float, ka->in[6]); P.lnw = AS_G(const float, ka->in[7]); P.lnb = AS_G(const float, ka->in[8]);
    P.lq1 = AS_G(const float, ka->in[9]); P.lk1 = AS_G(const float, ka->in[10]); P.lq2 = AS_G(const float, ka->in[11]); P.lk2 = AS_G(const float, ka->in[12]);
    P.subln = AS_G(const float, ka->in[13]); P.w_out = AS_G(const float, ka->in[14]); P.norm2_w = AS_G(const float, ka->in[15]); P.w_ff1 = AS_G(const float, ka->in[16]);
    P.w_ff2 = AS_G(const float, ka->in[17]); P.norm_f = AS_G(const float, ka->in[18]); P.out = AS_G(float, ka->out);
    P.mod = (float*)(ws + WS_MOD); P.cosT = (float*)(ws + WS_COS); P.sinT = (float*)(ws + WS_SIN); P.raw = (float*)(ws + WS_RAW); P.iw = (float*)(ws + WS_IW);
    P.Win = (bf16*)(ws + WS_WIN); P.Wout = (bf16*)(ws + WS_WOUT); P.W1 = (bf16*)(ws + WS_W1); P.W2 = (bf16*)(ws + WS_W2);
    P.QKV = (bf16*)(ws + WS_QKV); P.ODIFF = (bf16*)(ws + WS_ODIFF); P.MIX = (bf16*)(ws + WS_MIX); P.XN = (bf16*)(ws + WS_XN); P.IK = (bf16*)(ws + WS_IK); P.H = (bf16*)(ws + WS_H);
    P.WM = (unsigned long long*)(ws + WS_WM);
}
__global__ void __launch_bounds__(NWAVES * 64, 2) mega_fwd(Args args) {
    extern __shared__ __attribute__((aligned(16))) unsigned char lds[];
    Frame F;
    F.lds = (LAS unsigned char*)lds;
    F.MISC = (volatile LAS unsigned*)(F.lds + MISC_OFF);
    F.tid = threadIdx.x; F.lane = F.tid & 63; F.wave = __builtin_amdgcn_readfirstlane(F.tid >> 6);
    F.G = GRID; { const int bx = blockIdx.x; F.vcu = (bx % 8) * (GRID / 8) + bx / 8; }
#define BX_FROM_VCU ((F.vcu % (GRID / 8)) * 8 + F.vcu / (GRID / 8))
    F.ctl = (gu32*)(args.ws + WS_CTL);
#define PHASE_BEGIN() \
    Ptrs P; { KArgs ka = (KArgs)__builtin_amdgcn_kernarg_segment_ptr(); asm volatile("" : "+s"(ka)); fill_ptrs(P, ka); } \
    { int l_ = (int)__builtin_amdgcn_mbcnt_hi(~0u, __builtin_amdgcn_mbcnt_lo(~0u, 0u)); asm volatile("" : "+v"(l_)); F.lane = l_; F.tid = F.wave * 64 + l_; asm volatile("" : "+s"(F.vcu)); }
    for (int u = F.tid; u < (LDS_BYTES - LDSCTL_OFF) / 4; u += NWAVES * 64) ((LAS unsigned*)(F.lds + LDSCTL_OFF))[u] = 0u;
    __syncthreads();
    const int lo = args.ph_lo, hi = args.ph_hi;
    const bool single = (hi - lo) > 1;
    XcdBarrier bar; bar.bar = (unsigned*)(F.ctl + CW_BAR); bar.x = 0; bar.st = nullptr;
    if (single) bar = xcd_barrier_post((unsigned*)(F.ctl + CW_BAR), F.MISC + 8, F.tid);
#ifndef PH_REP
#define PH_REP 0
#endif
#ifndef PH_EN
#define PH_EN 0x7FF
#endif
#define IN(k) (((PH_EN >> (k)) & 1) && lo <= (k) && (k) < hi)
#define SEAM(k) do { if (IN(k) && IN((k) + 1)) { int l_ = (int)__builtin_amdgcn_mbcnt_hi(~0u, __builtin_amdgcn_mbcnt_lo(~0u, 0u)); xcd_barrier(bar, F.wave * 64 + l_); \
        if ((PH_REP & 0x1000) && (k) == 6) { for (int e_ = 0; e_ < 10; ++e_) xcd_barrier(bar, F.wave * 64 + l_); } } } while (0)
    typedef attn_body::bf16 abf;

    if (IN(0)) for (int rep_ = 0; rep_ <= ((PH_REP >> 0) & 1); ++rep_) { PHASE_BEGIN(); p0a(F, P); if (PH_REP & 1) __syncthreads(); } SEAM(0);
    if (IN(1)) for (int rep_ = 0; rep_ <= ((PH_REP >> 1) & 1); ++rep_) { PHASE_BEGIN(); norm_mod_pass(F, P, P.x, P.norm1_w, 1 * D, 0 * D); } SEAM(1);
    if (IN(2)) for (int rep_ = 0; rep_ <= ((PH_REP >> 2) & 1); ++rep_) { PHASE_BEGIN();
        pg8::Gemm g{P.XN, P.Win, M, NIN, D}; pg8::StaticOrder S; S.init(M, NIN, GRID, BX_FROM_VCU);
        pg8::EpiInProj E{P.QKV, P.raw, P.cosT, P.sinT, C2, M};
        pg8::gemm_phase<pg8::EpiInProj, pg8::StaticOrder, PG8_ALIGN, PG8_SP2>(F.lds + RING_OFF, g, S, E, F.tid);
    } SEAM(2);
    if (IN(3)) for (int rep_ = 0; rep_ <= ((PH_REP >> 3) & 1); ++rep_) { PHASE_BEGIN();
        ik_pass(F, P);
        const attn_body::AttnTensors AT{(const abf*)P.QKV + (size_t)4 * M * 512, (const abf*)P.QKV + (size_t)5 * M * 512, (const abf*)P.QKV + (size_t)6 * M * 512, (abf*)P.ODIFF, nullptr};
        const attn_body::DiffOrder S(F.vcu);
        attn_body::attn_phase<attn_body::DiffOrder, false, 512, 512, 1024, SEQ>((char*)lds + RING_OFF, AT, S, F.tid);
    } SEAM(3);
    if (IN(4)) for (int rep_ = 0; rep_ <= ((PH_REP >> 4) & 1); ++rep_) { PHASE_BEGIN();
        diff_combine_pass(F, P); if (PH_REP & 0x8000) diff_combine_pass(F, P);
        const int b = F.vcu >> 6, j = F.vcu & 63;
        for (int i = 0; i < 4; ++i) { const int qb = (i == 0) ? j : (i == 1) ? 127 - j : (i == 2) ? 128 + j : 255 - j; sel_unit(F, P, b, qb); }
    } SEAM(4);
    if (IN(5)) for (int rep_ = 0; rep_ <= ((PH_REP >> 5) & 1); ++rep_) { PHASE_BEGIN();
        const attn_body::AttnTensors AT{(const abf*)P.QKV, (const abf*)P.QKV + (size_t)1 * M * 512, (const abf*)P.QKV + (size_t)2 * M * 512, (abf*)P.MIX, P.WM};
        const attn_body::DsaOrder S(F.vcu);
        attn_body::attn_phase<attn_body::DsaOrder, true, 512, 512, 1024, SEQ>((char*)lds + RING_OFF, AT, S, F.tid);
    } SEAM(5);
    if (IN(6)) for (int rep_ = 0; rep_ <= ((PH_REP >> 6) & 1); ++rep_) { PHASE_BEGIN();
        pg8::Gemm g{P.MIX, P.Wout, M, D, D}; pg8::StaticOrder S; S.init(M, D, GRID, BX_FROM_VCU);
        pg8::EpiResGate E{P.x, P.out, P.mod + 2 * D, D, SEQ, NMOD};
        pg8::gemm_phase<pg8::EpiResGate, pg8::StaticOrder, PG8_ALIGN, PG8_SP2>(F.lds + RING_OFF, g, S, E, F.tid);
    } SEAM(6);
    if (IN(7)) for (int rep_ = 0; rep_ <= ((PH_REP >> 7) & 1); ++rep_) { PHASE_BEGIN(); norm_mod_pass(F, P, P.out, P.norm2_w, 4 * D, 3 * D); } SEAM(7);
    if (IN(8)) for (int rep_ = 0; rep_ <= ((PH_REP >> 8) & 1); ++rep_) { PHASE_BEGIN();
        pg8::Gemm g{P.XN, P.W1, M, FF, D}; pg8::StaticOrder S; S.init(M, FF, GRID, BX_FROM_VCU);
        pg8::EpiBf16<2> E{P.H, FF};
        pg8::gemm_phase<pg8::EpiBf16<2>, pg8::StaticOrder, PG8_ALIGN, PG8_SP2>(F.lds + RING_OFF, g, S, E, F.tid);
    } SEAM(8);
    if (IN(9)) for (int rep_ = 0; rep_ <= ((PH_REP >> 9) & 1); ++rep_) { PHASE_BEGIN();
        pg8::Gemm g{P.H, P.W2, M, D, FF}; pg8::StaticOrder S; S.init(M, D, GRID, BX_FROM_VCU);
        pg8::EpiResGate E{P.out, P.out, P.mod + 5 * D, D, SEQ, NMOD};
        pg8::gemm_phase<pg8::EpiResGate, pg8::StaticOrder, PG8_ALIGN, PG8_SP2>(F.lds + RING_OFF, g, S, E, F.tid);
    } SEAM(9);
    if (IN(10)) for (int rep_ = 0; rep_ <= ((PH_REP >> 10) & 1); ++rep_) { PHASE_BEGIN(); final_norm_pass(F, P); }
#undef IN
#undef SEAM
}

#ifndef MK_PER_PHASE
#define MK_PER_PHASE 0
#endif
extern "C" void kernel_launch(void* const* d_in, const int* in_sizes, int n_in, void* d_out, int out_size, void* d_ws, size_t ws_size, hipStream_t stream) {
    static int grid = 0;
    if (grid == 0) {
        if (n_in != 19 || in_sizes[0] != M * D || out_size != M * D || ws_size < WS_END) { fprintf(stderr, "kernel_launch: unexpected shapes (n_in %d, in0 %d, out %d, ws %zu); nothing launched\n", n_in, n_in > 0 ? in_sizes[0] : -1, out_size, ws_size); grid = -1; return; }
        int dev = 0, cus = 0, per_cu = 0;
        if (hipGetDevice(&dev) != hipSuccess || hipDeviceGetAttribute(&cus, hipDeviceAttributeMultiprocessorCount, dev) != hipSuccess) { grid = -1; return; }
        if (hipFuncSetAttribute((const void*)mega_fwd, hipFuncAttributeMaxDynamicSharedMemorySize, LDS_BYTES) != hipSuccess) { fprintf(stderr, "kernel_launch: hipFuncSetAttribute failed\n"); grid = -1; return; }
        if (hipOccupancyMaxActiveBlocksPerMultiprocessor(&per_cu, (const void*)mega_fwd, NWAVES * 64, LDS_BYTES) != hipSuccess || per_cu < 1)
            fprintf(stderr, "kernel_launch: note: occupancy query reports %d workgroups per CU\n", per_cu);
        (void)hipGetLastError();
        grid = GRID;
        if (cus != 256) fprintf(stderr, "kernel_launch: device reports %d CUs; this kernel is scheduled for 256\n", cus);
    }
    if (grid < 0) return;
    if (hipMemsetAsync((char*)d_ws + WS_CTL, 0, CTL_ZERO_BYTES, stream) != hipSuccess) { fprintf(stderr, "kernel_launch: hipMemsetAsync failed\n"); return; }
    Args a; memset(&a, 0, sizeof(a));
    for (int i = 0; i < 19; ++i) a.in[i] = d_in[i];
    a.out = (float*)d_out; a.ws = (unsigned char*)d_ws;
#if MK_PER_PHASE
    for (int ph = 0; ph < N_PHASES; ++ph) { a.ph_lo = ph; a.ph_hi = ph + 1; hipLaunchKernelGGL(mega_fwd, dim3(grid), dim3(NWAVES * 64), LDS_BYTES, stream, a); }
#else
    a.ph_lo = 0; a.ph_hi = N_PHASES;
    hipLaunchKernelGGL(mega_fwd, dim3(grid), dim3(NWAVES * 64), LDS_BYTES, stream, a);
#endif
    const hipError_t le = hipPeekAtLastError();
    if (le != hipSuccess) fprintf(stderr, "kernel_launch: launch failed: %s\n", hipGetErrorName(le));
}
```
